# Optimizing an MI355X kernel written in HIP

```python
import math
import jax, jax.numpy as jnp
from jax import lax
import numpy as np

D_MODEL = 1024
BATCH = 2
SEQ = 16384
DEPTH = 1
DEC_BATCH = 8
DEC_SEQ = 4096
PAST_LEN = 128

GRID_W = 64
NA_HEADS = 8
NA_HEAD_DIM = 64
NA_WIDTH = NA_HEADS * NA_HEAD_DIM
WIN_ROWS = 8
WIN_COLS = 16
SGU_GROUPS = 8
SGU_GROUP_DIM = 64
SGU_WIDTH = SGU_GROUPS * SGU_GROUP_DIM
CHUNK = 128
D_FF = 4 * D_MODEL
IN_WIDTH = 3 * NA_WIDTH + 2 * SGU_WIDTH + 2 * D_MODEL
N_ADA = 6
ALPHA = (2.0 * DEPTH) ** 0.25
BETA = (8.0 * DEPTH) ** -0.25
LN_EPS = 1e-5

kernel_name = "hybrid_natten_gmlp_deepnorm_adaln_encoder"


def layer_norm(x, g, b):
    xf = x.astype(jnp.float32)
    mu = jnp.mean(xf, axis=-1, keepdims=True)
    var = jnp.mean(jnp.square(xf - mu), axis=-1, keepdims=True)
    y = (xf - mu) * lax.rsqrt(var + LN_EPS) * g.astype(jnp.float32) + b.astype(jnp.float32)
    return y.astype(x.dtype)


def neighborhood_attention(q, k, v, rpb):
    B, T, H, dh = q.shape
    rows = T // GRID_W
    wr = min(WIN_ROWS, rows)
    qg = q.reshape(B, rows, GRID_W, H, dh) * (dh ** -0.5)
    kg = k.reshape(B, rows, GRID_W, H, dh)
    vg = v.reshape(B, rows, GRID_W, H, dh)
    col = jnp.arange(GRID_W)
    col_start = jnp.clip(col - WIN_COLS // 2, 0, GRID_W - WIN_COLS)
    col_idx = col_start[:, None] + jnp.arange(WIN_COLS)[None, :]
    dcol = col_idx - col[:, None] + (WIN_COLS - 1)
    rpb_c = jnp.transpose(rpb[:, :, dcol], (0, 2, 1, 3)).astype(jnp.float32)

    def row_fn(r):
        rs = jnp.clip(r - WIN_ROWS // 2, 0, rows - wr)
        k_rows = lax.dynamic_slice_in_dim(kg, rs, wr, axis=1)
        v_rows = lax.dynamic_slice_in_dim(vg, rs, wr, axis=1)
        k_win = k_rows[:, :, col_idx]
        v_win = v_rows[:, :, col_idx]
        q_r = lax.dynamic_index_in_dim(qg, r, axis=1, keepdims=False)
        s = jnp.einsum('bqhd,biqjhd->bhqij', q_r, k_win).astype(jnp.float32)
        drow = rs + jnp.arange(wr) - r + (WIN_ROWS - 1)
        s = s + rpb_c[:, :, drow][None]
        p = jax.nn.softmax(s.reshape(B, H, GRID_W, wr * WIN_COLS), axis=-1)
        p = p.reshape(B, H, GRID_W, wr, WIN_COLS).astype(v.dtype)
        return jnp.einsum('bhqij,biqjhd->bqhd', p, v_win)

    out = lax.map(row_fn, jnp.arange(rows))
    return jnp.transpose(out, (1, 0, 2, 3, 4)).reshape(B, T, H * dh)


def spatial_gating(u, vs, ln_g, ln_b, w_s, b_s):
    B, T, _ = vs.shape
    vs = layer_norm(vs, ln_g, ln_b)
    vc = vs.reshape(B, T // CHUNK, CHUNK, SGU_GROUPS, SGU_GROUP_DIM)
    s = jnp.einsum('gpq,bnqgc->bnpgc', w_s, vc) + jnp.transpose(b_s)[None, None, :, :, None]
    return u * s.reshape(B, T, SGU_WIDTH)


def encoder_layer(x, c, w_ada, b_ada, w_in, rpb, sgu_ln_g, sgu_ln_b, w_s, b_s,
                  w_attn_up, w_sgu_up, w_o, ln1_g, ln1_b, w_ff1, b_ff1, w_ff2, b_ff2,
                  ln2_g, ln2_b):
    B, T, _ = x.shape
    ada = jax.nn.silu(c) @ w_ada + b_ada
    shift1, scale1, gate1, shift2, scale2, gate2 = [a[:, None, :] for a in jnp.split(ada, N_ADA, axis=-1)]

    h = x * (1.0 + scale1) + shift1
    z = h @ w_in
    splits = np.cumsum([NA_WIDTH, NA_WIDTH, NA_WIDTH, SGU_WIDTH, SGU_WIDTH, D_MODEL]).tolist()
    q, k, v, u, vs, ga, gb = jnp.split(z, splits, axis=-1)
    attn = neighborhood_attention(q.reshape(B, T, NA_HEADS, NA_HEAD_DIM),
                                  k.reshape(B, T, NA_HEADS, NA_HEAD_DIM),
                                  v.reshape(B, T, NA_HEADS, NA_HEAD_DIM), rpb)
    sgu = spatial_gating(jax.nn.gelu(u), jax.nn.gelu(vs), sgu_ln_g, sgu_ln_b, w_s, b_s)
    merged = jax.nn.sigmoid(ga) * (attn @ w_attn_up) + jax.nn.sigmoid(gb) * (sgu @ w_sgu_up)
    mix = merged @ w_o
    x = layer_norm(ALPHA * x + gate1 * mix, ln1_g, ln1_b)

    h = x * (1.0 + scale2) + shift2
    f = jnp.square(jax.nn.relu(h @ w_ff1 + b_ff1)) @ w_ff2 + b_ff2
    x = layer_norm(ALPHA * x + gate2 * f, ln2_g, ln2_b)
    return x


def run_trunk(x, c, w_ada, b_ada, w_in, rpb, sgu_ln_g, sgu_ln_b, w_s, b_s,
              w_attn_up, w_sgu_up, w_o, ln1_g, ln1_b, w_ff1, b_ff1, w_ff2, b_ff2,
              ln2_g, ln2_b):
    for l in range(DEPTH):
        x = encoder_layer(x, c, w_ada[l], b_ada[l], w_in[l], rpb[l], sgu_ln_g[l], sgu_ln_b[l],
                          w_s[l], b_s[l], w_attn_up[l], w_sgu_up[l], w_o[l], ln1_g[l], ln1_b[l],
                          w_ff1[l], b_ff1[l], w_ff2[l], b_ff2[l], ln2_g[l], ln2_b[l])
    return x


def setup_inputs(seed: int = 0) -> dict:
    key = jax.random.key(seed)
    ks = jax.random.split(key, 24)
    f32 = jnp.float32
    L, D = DEPTH, D_MODEL

    def nrm(k, shape, std):
        return jax.random.normal(k, shape, f32) * std

    return {
        "x_prompt": nrm(ks[0], (BATCH, SEQ, D), 1.0),
        "x_sample": nrm(ks[1], (DEC_BATCH, DEC_SEQ, D), 1.0),
        "c_prompt": nrm(ks[2], (BATCH, D), 1.0),
        "c_sample": nrm(ks[3], (DEC_BATCH, D), 1.0),
        "w_ada": nrm(ks[4], (L, D, N_ADA * D), 0.5 * D ** -0.5),
        "b_ada": nrm(ks[5], (L, N_ADA * D), 0.02),
        "w_in": nrm(ks[6], (L, D, IN_WIDTH), D ** -0.5),
        "rpb": nrm(ks[7], (L, NA_HEADS, 2 * WIN_ROWS - 1, 2 * WIN_COLS - 1), 0.1),
        "sgu_ln_g": 1.0 + nrm(ks[8], (L, SGU_WIDTH), 0.02),
        "sgu_ln_b": nrm(ks[9], (L, SGU_WIDTH), 0.02),
        "w_s": nrm(ks[10], (L, SGU_GROUPS, CHUNK, CHUNK), 0.5 * CHUNK ** -0.5),
        "b_s": 1.0 + nrm(ks[11], (L, SGU_GROUPS, CHUNK), 0.02),
        "w_attn_up": nrm(ks[12], (L, NA_WIDTH, D), NA_WIDTH ** -0.5),
        "w_sgu_up": nrm(ks[13], (L, SGU_WIDTH, D), SGU_WIDTH ** -0.5),
        "w_o": nrm(ks[14], (L, D, D), BETA * D ** -0.5),
        "ln1_g": 1.0 + nrm(ks[15], (L, D), 0.02),
        "ln1_b": nrm(ks[16], (L, D), 0.02),
        "w_ff1": nrm(ks[17], (L, D, D_FF), D ** -0.5),
        "b_ff1": nrm(ks[18], (L, D_FF), 0.02),
        "w_ff2": nrm(ks[19], (L, D_FF, D), BETA * D_FF ** -0.5),
        "b_ff2": nrm(ks[20], (L, D), 0.02),
        "ln2_g": 1.0 + nrm(ks[21], (L, D), 0.02),
        "ln2_b": nrm(ks[22], (L, D), 0.02),
    }


def reference(x_prompt, x_sample, c_prompt, c_sample, w_ada, b_ada, w_in, rpb, sgu_ln_g, sgu_ln_b,
              w_s, b_s, w_attn_up, w_sgu_up, w_o, ln1_g, ln1_b, w_ff1, b_ff1, w_ff2, b_ff2,
              ln2_g, ln2_b):
    y_prompt = run_trunk(x_prompt, c_prompt, w_ada, b_ada, w_in, rpb, sgu_ln_g, sgu_ln_b, w_s, b_s,
                         w_attn_up, w_sgu_up, w_o, ln1_g, ln1_b, w_ff1, b_ff1, w_ff2, b_ff2,
                         ln2_g, ln2_b)
    y_sample = run_trunk(x_sample, c_sample, w_ada, b_ada, w_in, rpb, sgu_ln_g, sgu_ln_b, w_s, b_s,
                         w_attn_up, w_sgu_up, w_o, ln1_g, ln1_b, w_ff1, b_ff1, w_ff2, b_ff2,
                         ln2_g, ln2_b)
    return (y_prompt, y_sample)
```

```cpp
#include <hip/hip_runtime.h>
#include <hip/hip_cooperative_groups.h>
#include <cstdio>
namespace cg = cooperative_groups;
#ifndef MK_MULTI
#define MK_MULTI 0
#endif
namespace pg8 {
#define PG8_LAS __attribute__((address_space(3)))
typedef unsigned short bf16_t;
typedef short bf16x8 __attribute__((ext_vector_type(8)));
typedef float f32x4 __attribute__((ext_vector_type(4)));
typedef unsigned u32x4 __attribute__((ext_vector_type(4)));
constexpr int BM = 256, BK = 64, HALF = 128, HTB = HALF * BK * 2  , STAGE_BYTES = 8 * HTB, NXCD = 8, WGM = 8;

__host__ __device__ __forceinline__ int lds_byte(int r, int c) { const int st = (r >> 4) * 2 + (c >> 5), rr = r & 15, cc = c & 31, ob = rr * 64 + cc * 2; return st * 1024 + (ob ^ (((ob >> 9) & 1) << 5)); }
__host__ __device__ __forceinline__ void stage_rc(int b, int& R, int& C) { const int st = b / 1024, sb = b % 1024, swz = sb ^ (((sb >> 9) & 1) << 5); R = (st >> 1) * 16 + swz / 64; C = (st & 1) * 32 + (swz % 64) / 2; }
__host__ __device__ __forceinline__ int perm32(int rho) { const int n = rho >> 4, i = rho & 15; return 8 * (i >> 2) + 4 * n + (i & 3); }

struct Unit { int pm, pn; };
struct Gemm { const bf16_t* A; const bf16_t* Bt; int M, N, K; };

struct StaticOrder {
    int nM, nN, nwg, G, c;
    __host__ __device__ void init(int M, int N, int G_, int c_) { nM = M / BM; nN = N / BM; nwg = nM * nN; G = G_; c = c_; }
    __host__ __device__ bool next(int i, Unit& u) const {
        const long L = (long)i * G + c; if (L >= nwg) return false;
        int wgid = (int)L; { const int q = nwg / NXCD, r = nwg % NXCD, xcd = wgid % NXCD, off = wgid / NXCD; wgid = (xcd < r ? xcd * (q + 1) : r * (q + 1) + (xcd - r) * q) + off; }
        const int nig = WGM * nN, gid = wgid / nig, fm = gid * WGM, gsz = (nM - fm) < WGM ? (nM - fm) : WGM;
        u.pm = fm + ((wgid % nig) % gsz); u.pn = (wgid % nig) / gsz; return true;
    }
    __device__ __forceinline__ void a_ready(const Unit&) const {}
    __device__ __forceinline__ void done(const Unit&) const {}
};
__device__ __forceinline__ unsigned cvt_pk_bf16(float lo, float hi) { unsigned r; asm volatile("v_cvt_pk_bf16_f32 %0, %1, %2" : "=v"(r) : "v"(lo), "v"(hi)); return r; }
typedef float f32x2 __attribute__((ext_vector_type(2)));
__device__ __forceinline__ f32x2 gelu_pk(f32x2 v) {
    const f32x2 av = __builtin_elementwise_abs(v), d = av * 0.2316418882f + 1.0f;
    f32x2 t; t.x = __builtin_amdgcn_rcpf(d.x); t.y = __builtin_amdgcn_rcpf(d.y);
    f32x2 q = t * 0.5307027145f + (-0.7265760135f); q = q * t + 0.7107068705f; q = q * t + (-0.142248368f); q = q * t + 0.127414796f; q = q * t;
    const f32x2 s = (v * v) * (-0.72134752044f);
    f32x2 e; e.x = __builtin_amdgcn_exp2f(s.x); e.y = __builtin_amdgcn_exp2f(s.y);
    const f32x2 m = v * (q * e), r = v - m;
    f32x2 o; o.x = v.x < 0.f ? m.x : r.x; o.y = v.y < 0.f ? m.y : r.y; return o;
}
template <class Epi, class Sched, bool STAMP = false>
__device__ __forceinline__ void gemm_phase(PG8_LAS unsigned char* lds, const Gemm g, const Sched& S, const Epi& E, unsigned long long* stamps) {
    int tid_l = threadIdx.x; asm volatile("" : "+v"(tid_l)); const int tid = tid_l, wid = __builtin_amdgcn_readfirstlane(tid >> 6), lane = tid & 63, wr = wid >> 2, wc = wid & 3, fr = lane & 15, fq = lane >> 4;
    const int K = g.K, nt = K / BK;
    int ts_lo = 0, ts_hi = 0, nts = 0; const unsigned long long rt_entry = STAMP ? (unsigned long long)wall_clock64() : 0ull;
#define PG8_STAMP() do { if (STAMP && wid == 0 && nts < 64) { const unsigned long long _c = (unsigned long long)clock64(); \
        ts_lo = (lane == nts) ? (int)(unsigned)_c : ts_lo; ts_hi = (lane == nts) ? (int)(unsigned)(_c >> 32) : ts_hi; ++nts; } } while (0)
    PG8_STAMP();
    unsigned voffA[2], voffB[2];
#pragma unroll
    for (int i = 0; i < 2; ++i) { int R, C; stage_rc(tid * 16 + i * 8192, R, C); const int Rb = Epi::PERM ? ((R & ~31) + perm32(R & 31)) : R;
        voffA[i] = (unsigned)(R * K + C) * 2u; voffB[i] = (unsigned)(Rb * K + C) * 2u; }
    const size_t kstep = (size_t)(BK * 2);
    const size_t hstep = (size_t)HALF * K * 2;
    const size_t tstep = 2 * hstep;
    const unsigned ldsw = (unsigned)wid * 1024u;
    const int aoff = lds_byte(wr * 64 + fr, fq * 8), boff = lds_byte(wc * 32 + fr, fq * 8);
#define PG8_SA(b, h) (((b) * 2 + (h)) * HTB)
#define PG8_SB(b, h) ((4 + (b) * 2 + (h)) * HTB)
#define PG8_STAGE(bufoff, gbase, voff) do { _Pragma("unroll") for (int _i = 0; _i < 2; ++_i) \
        __builtin_amdgcn_global_load_lds((const unsigned*)((const char*)(gbase) + (voff)[_i]), (PG8_LAS unsigned*)(lds + (bufoff) + ldsw + _i * 8192), 16, 0, 0); } while (0)
#define PG8_LDA(dst, b, h) do { _Pragma("unroll") for (int m = 0; m < 4; ++m) _Pragma("unroll") for (int k = 0; k < 2; ++k) dst[m][k] = *(const PG8_LAS bf16x8*)(lds + PG8_SA(b, h) + aoff + m * 2048 + k * 1024); } while (0)
#define PG8_LDB(dst, b, h) do { _Pragma("unroll") for (int n = 0; n < 2; ++n) _Pragma("unroll") for (int k = 0; k < 2; ++k) dst[n][k] = *(const PG8_LAS bf16x8*)(lds + PG8_SB(b, h) + boff + n * 2048 + k * 1024); } while (0)
#define PG8_MMA(ai, bj, At, Bt) do { __builtin_amdgcn_s_setprio(1); _Pragma("unroll") for (int m = 0; m < 4; ++m) _Pragma("unroll") for (int n = 0; n < 2; ++n) _Pragma("unroll") for (int k = 0; k < 2; ++k) \
        acc[ai][bj][m][n] = __builtin_amdgcn_mfma_f32_16x16x32_bf16(Bt[n][k], At[m][k], acc[ai][bj][m][n], 0, 0, 0); __builtin_amdgcn_s_setprio(0); } while (0)
#define PG8_WAIT_V(n) asm volatile("s_waitcnt vmcnt(" #n ")" ::: "memory")
#define PG8_WAIT_L(n) asm volatile("s_waitcnt lgkmcnt(" #n ")" ::: "memory")
#define PG8_BAR __builtin_amdgcn_s_barrier()
#define PG8_SCHED __builtin_amdgcn_sched_barrier(0)
    Unit cur, nxt; int ui = 0;
    if (!S.next(0, cur)) return;
    f32x4 acc[2][2][4][2];
#pragma unroll
    for (int a = 0; a < 2; ++a)
#pragma unroll
        for (int b = 0; b < 2; ++b)
#pragma unroll
            for (int m = 0; m < 4; ++m)
#pragma unroll
                for (int n = 0; n < 2; ++n) acc[a][b][m][n] = (f32x4){0.f, 0.f, 0.f, 0.f};
    bf16x8 At[4][2], B0[2][2], B1[2][2];
    const char* cA = (const char*)g.A + (size_t)cur.pm * tstep; const char* cB = (const char*)g.Bt + (size_t)cur.pn * tstep;
    S.a_ready(cur);
    PG8_STAGE(PG8_SB(0, 0), cB, voffB); PG8_STAGE(PG8_SA(0, 0), cA, voffA); PG8_STAGE(PG8_SB(0, 1), cB + hstep, voffB); PG8_STAGE(PG8_SA(0, 1), cA + hstep, voffA);
    if (wr == 1) PG8_BAR;
    PG8_WAIT_V(4); PG8_BAR;
    PG8_STAGE(PG8_SB(1, 0), cB + kstep, voffB); PG8_STAGE(PG8_SA(1, 0), cA + kstep, voffA); PG8_STAGE(PG8_SB(1, 1), cB + hstep + kstep, voffB);
    PG8_WAIT_V(6); PG8_BAR;
    PG8_STAMP();
    for (;;) {
        const bool has_next = S.next(ui + 1, nxt);
        const char* nA = has_next ? (const char*)g.A + (size_t)nxt.pm * tstep : cA; const char* nB = has_next ? (const char*)g.Bt + (size_t)nxt.pn * tstep : cB;
        for (int t = 0; t < nt; t += 2) {
            const bool last = (t == nt - 2);
            const char* a1 = cA + (size_t)(t + 1) * kstep;
            const char* a2 = last ? nA : cA + (size_t)(t + 2) * kstep; const char* b2 = last ? nB : cB + (size_t)(t + 2) * kstep;
            const char* a3 = a2 + kstep; const char* b3 = b2 + kstep;
            if (last && has_next) S.a_ready(nxt);
            PG8_LDB(B0, 0, 0); PG8_SCHED; PG8_LDA(At, 0, 0); PG8_STAGE(PG8_SA(1, 1), a1 + hstep, voffA);
            PG8_WAIT_L(8); PG8_BAR; PG8_WAIT_L(0); PG8_MMA(0, 0, At, B0); PG8_BAR; PG8_SCHED;
            PG8_LDB(B1, 0, 1); PG8_STAGE(PG8_SB(0, 0), b2, voffB);
            PG8_BAR; PG8_WAIT_L(0); PG8_MMA(0, 1, At, B1); PG8_BAR;
            PG8_LDA(At, 0, 1); PG8_STAGE(PG8_SA(0, 0), a2, voffA);
            PG8_BAR; PG8_WAIT_L(0); PG8_MMA(1, 0, At, B0); PG8_BAR; PG8_SCHED;
            PG8_STAGE(PG8_SB(0, 1), b2 + hstep, voffB);
            PG8_WAIT_V(6); PG8_BAR; PG8_MMA(1, 1, At, B1); PG8_BAR;
            PG8_LDB(B0, 1, 0); PG8_SCHED; PG8_LDA(At, 1, 0); PG8_STAGE(PG8_SA(0, 1), a2 + hstep, voffA);
            PG8_WAIT_L(8); PG8_BAR; PG8_WAIT_L(0); PG8_MMA(0, 0, At, B0); PG8_BAR; PG8_SCHED;
            PG8_LDB(B1, 1, 1); PG8_STAGE(PG8_SB(1, 0), b3, voffB);
            PG8_BAR; PG8_WAIT_L(0); PG8_MMA(0, 1, At, B1); PG8_BAR;
            PG8_LDA(At, 1, 1); PG8_STAGE(PG8_SA(1, 0), a3, voffA);
            PG8_BAR; PG8_WAIT_L(0); PG8_MMA(1, 0, At, B0); PG8_BAR; PG8_SCHED;
            PG8_STAGE(PG8_SB(1, 1), b3 + hstep, voffB);
            PG8_WAIT_V(6); PG8_BAR; PG8_MMA(1, 1, At, B1); PG8_BAR;
        }
        PG8_STAMP();
        if constexpr (!Epi::AFTER_DRAIN) { E(acc, cur, wr, wc, fr, fq); S.done(cur); }
        PG8_STAMP();
        if (!has_next) break;
#pragma unroll
        for (int a = 0; a < 2; ++a)
#pragma unroll
            for (int b = 0; b < 2; ++b)
#pragma unroll
                for (int m = 0; m < 4; ++m)
#pragma unroll
                    for (int n = 0; n < 2; ++n) acc[a][b][m][n] = (f32x4){0.f, 0.f, 0.f, 0.f};
        cur = nxt; cA = nA; cB = nB; ++ui;
    }
    PG8_WAIT_V(0);
    if (wr == 0) PG8_BAR;
    PG8_BAR;
    if constexpr (Epi::AFTER_DRAIN) { E.fused(acc, cur, wr, wc, fr, fq, lds, wid, lane); S.done(cur); }
    PG8_STAMP();
    if (STAMP && wid == 0) { stamps[lane] = lane < nts ? (((unsigned long long)(unsigned)ts_hi << 32) | (unsigned)ts_lo) : 0ull;
        if (lane == 62) stamps[62] = rt_entry; if (lane == 63) stamps[63] = (unsigned long long)wall_clock64(); }
#undef PG8_STAMP
#undef PG8_SA
#undef PG8_SB
#undef PG8_STAGE
#undef PG8_LDA
#undef PG8_LDB
#undef PG8_MMA
#undef PG8_WAIT_V
#undef PG8_WAIT_L
#undef PG8_BAR
#undef PG8_SCHED
}
}
#define LAS __attribute__((address_space(3)))
typedef unsigned short bf16_t;
using pg8::bf16x8; using pg8::f32x4; using pg8::u32x4;
typedef unsigned u32x2 __attribute__((ext_vector_type(2)));
typedef float f32x2v __attribute__((ext_vector_type(2)));

constexpr int D = 1024, DFF = 4096, NTOK = 32768, NPH = 19;
constexpr float ALPHA = 1.189207115002721f, LN_EPS = 1e-5f;
constexpr int LDS_BYTES = 147456, LDS_STAT = 131072, LDS_RPB = 132096;
constexpr size_t MiB = 1048576;
constexpr size_t WS_ADA = 0, WS_WSB = 262144, WS_WIN = 524288, WS_WA = WS_WIN + 9 * MiB, WS_WS = WS_WA + MiB, WS_WO = WS_WS + MiB, WS_W1 = WS_WO + 2 * MiB,
                 WS_W2 = WS_W1 + 8 * MiB, WS_H = 30 * MiB, WS_Z = WS_H + 64 * MiB, WS_VT = WS_Z + 256 * MiB, WS_ATT = WS_VT + 32 * MiB, WS_SGU = WS_ATT + 32 * MiB,
                 WS_END = WS_SGU + 32 * MiB;

__device__ __forceinline__ unsigned pk2(float lo, float hi) { return pg8::cvt_pk_bf16(lo, hi); }
__device__ __forceinline__ float bflo(unsigned w) { return __uint_as_float(w << 16); }
__device__ __forceinline__ float bfhi(unsigned w) { return __uint_as_float(w & 0xffff0000u); }
__device__ __forceinline__ float sigmoidf_(float x) { return __builtin_amdgcn_rcpf(1.0f + __expf(-x)); }
__device__ __forceinline__ float gelu_tanh(float x) { const float t = x * (1.5957691216057308f + 0.07135481627260025f * x * x); return x * __builtin_amdgcn_rcpf(1.0f + __expf(-t)); }

struct EpiZ {
    static constexpr bool PERM = true, AFTER_DRAIN = false;
    bf16_t* O;
    __device__ __forceinline__ void operator()(const f32x4 (&acc)[2][2][4][2], const pg8::Unit& u, int wr, int wc, int fr, int fq) const {
        const int row0 = u.pm * 256 + wr * 64 + fr;
        bf16_t* base = O + (size_t)(u.pn >> 2) * ((size_t)NTOK * 1024) + ((u.pn & 3) * 256 + wc * 32 + 8 * fq);
        const int mode = u.pn < 2 ? 0 : (u.pn < 4 ? 1 : (u.pn < 8 ? 2 : 3));
#pragma unroll
        for (int ai = 0; ai < 2; ++ai)
#pragma unroll
            for (int m = 0; m < 4; ++m) { bf16_t* rowp = base + (size_t)(row0 + ai * 128 + m * 16) * 1024;
#pragma unroll
                for (int bj = 0; bj < 2; ++bj) { f32x4 v0 = acc[ai][bj][m][0], v1 = acc[ai][bj][m][1];
                    if (mode == 0) { v0 *= 0.125f; v1 *= 0.125f; }
                    else if (mode == 2) {
#pragma unroll
                        for (int j = 0; j < 4; ++j) { v0[j] = gelu_tanh(v0[j]); v1[j] = gelu_tanh(v1[j]); } }
                    else if (mode == 3) {
#pragma unroll
                        for (int j = 0; j < 4; ++j) { v0[j] = sigmoidf_(v0[j]); v1[j] = sigmoidf_(v1[j]); } }
                    u32x4 w; w.x = pk2(v0[0], v0[1]); w.y = pk2(v0[2], v0[3]); w.z = pk2(v1[0], v1[1]); w.w = pk2(v1[2], v1[3]);
                    *(u32x4*)(rowp + bj * 128) = w; } }
    }
};
struct EpiPlain {
    static constexpr bool PERM = true, AFTER_DRAIN = false;
    bf16_t* O; int ldc;
    __device__ __forceinline__ void operator()(const f32x4 (&acc)[2][2][4][2], const pg8::Unit& u, int wr, int wc, int fr, int fq) const {
        const int row0 = u.pm * 256 + wr * 64 + fr, col0 = u.pn * 256 + wc * 32 + 8 * fq;
#pragma unroll
        for (int ai = 0; ai < 2; ++ai)
#pragma unroll
            for (int m = 0; m < 4; ++m) { bf16_t* rowp = O + (size_t)(row0 + ai * 128 + m * 16) * ldc + col0;
#pragma unroll
                for (int bj = 0; bj < 2; ++bj) { const f32x4 v0 = acc[ai][bj][m][0], v1 = acc[ai][bj][m][1];
                    u32x4 w; w.x = pk2(v0[0], v0[1]); w.y = pk2(v0[2], v0[3]); w.z = pk2(v1[0], v1[1]); w.w = pk2(v1[2], v1[3]);
                    *(u32x4*)(rowp + bj * 128) = w; } }
    }
};
template <int STEP> struct EpiGate {
    static constexpr bool PERM = true, AFTER_DRAIN = false;
    const bf16_t* G; bf16_t* O;
    __device__ __forceinline__ void operator()(const f32x4 (&acc)[2][2][4][2], const pg8::Unit& u, int wr, int wc, int fr, int fq) const {
        const int row0 = u.pm * 256 + wr * 64 + fr, col0 = u.pn * 256 + wc * 32 + 8 * fq;
#pragma unroll
        for (int ai = 0; ai < 2; ++ai)
#pragma unroll
            for (int m = 0; m < 4; ++m) { const size_t off = (size_t)(row0 + ai * 128 + m * 16) * 1024 + col0;
#pragma unroll
                for (int bj = 0; bj < 2; ++bj) { const f32x4 v0 = acc[ai][bj][m][0], v1 = acc[ai][bj][m][1];
                    const u32x4 g = *(const u32x4*)(G + off + bj * 128);
                    float o0 = bflo(g.x) * v0[0], o1 = bfhi(g.x) * v0[1], o2 = bflo(g.y) * v0[2], o3 = bfhi(g.y) * v0[3];
                    float o4 = bflo(g.z) * v1[0], o5 = bfhi(g.z) * v1[1], o6 = bflo(g.w) * v1[2], o7 = bfhi(g.w) * v1[3];
                    if (STEP == 1) { const u32x4 p = *(const u32x4*)(O + off + bj * 128);
                        o0 += bflo(p.x); o1 += bfhi(p.x); o2 += bflo(p.y); o3 += bfhi(p.y); o4 += bflo(p.z); o5 += bfhi(p.z); o6 += bflo(p.w); o7 += bfhi(p.w); }
                    u32x4 w; w.x = pk2(o0, o1); w.y = pk2(o2, o3); w.z = pk2(o4, o5); w.w = pk2(o6, o7);
                    *(u32x4*)(O + off + bj * 128) = w; } }
    }
};
struct EpiRes {
    static constexpr bool PERM = false, AFTER_DRAIN = false;
    const float* X; float* Y; const float* ada_gate; const float* bias; int bb0, bsh;
    __device__ __forceinline__ void operator()(const f32x4 (&acc)[2][2][4][2], const pg8::Unit& u, int wr, int wc, int fr, int fq) const {
        const int row0 = u.pm * 256 + wr * 64 + fr, col0 = u.pn * 256 + wc * 32 + 4 * fq;
        const float* gp = ada_gate + (size_t)(bb0 + (u.pm >> bsh)) * 6144 + col0;
        f32x4 gv[2][2], bv[2][2];
#pragma unroll
        for (int bj = 0; bj < 2; ++bj)
#pragma unroll
            for (int n = 0; n < 2; ++n) { gv[bj][n] = *(const f32x4*)(gp + bj * 128 + n * 16); bv[bj][n] = bias ? *(const f32x4*)(bias + col0 + bj * 128 + n * 16) : (f32x4){0.f, 0.f, 0.f, 0.f}; }
#pragma unroll
        for (int ai = 0; ai < 2; ++ai)
#pragma unroll
            for (int m = 0; m < 4; ++m) { const size_t off = (size_t)(row0 + ai * 128 + m * 16) * 1024 + col0;
#pragma unroll
                for (int bj = 0; bj < 2; ++bj)
#pragma unroll
                    for (int n = 0; n < 2; ++n) { const f32x4 x = *(const f32x4*)(X + off + bj * 128 + n * 16);
                        *(f32x4*)(Y + off + bj * 128 + n * 16) = x * ALPHA + gv[bj][n] * (acc[ai][bj][m][n] + bv[bj][n]); }
                asm volatile("" ::: "memory"); }
    }
};
struct EpiFF1 {
    static constexpr bool PERM = true, AFTER_DRAIN = false;
    bf16_t* O; const float* bias;
    __device__ __forceinline__ void operator()(const f32x4 (&acc)[2][2][4][2], const pg8::Unit& u, int wr, int wc, int fr, int fq) const {
        const int row0 = u.pm * 256 + wr * 64 + fr, col0 = u.pn * 256 + wc * 32 + 8 * fq;
        f32x4 bv[2][2];
#pragma unroll
        for (int bj = 0; bj < 2; ++bj)
#pragma unroll
            for (int n = 0; n < 2; ++n) bv[bj][n] = *(const f32x4*)(bias + col0 + bj * 128 + 4 * n);
#pragma unroll
        for (int ai = 0; ai < 2; ++ai)
#pragma unroll
            for (int m = 0; m < 4; ++m) { bf16_t* rowp = O + (size_t)(row0 + ai * 128 + m * 16) * DFF + col0;
#pragma unroll
                for (int bj = 0; bj < 2; ++bj) { f32x4 v0 = acc[ai][bj][m][0] + bv[bj][0], v1 = acc[ai][bj][m][1] + bv[bj][1];
#pragma unroll
                    for (int j = 0; j < 4; ++j) { v0[j] = fmaxf(v0[j], 0.f); v0[j] *= v0[j]; v1[j] = fmaxf(v1[j], 0.f); v1[j] *= v1[j]; }
                    u32x4 w; w.x = pk2(v0[0], v0[1]); w.y = pk2(v0[2], v0[3]); w.z = pk2(v1[0], v1[1]); w.w = pk2(v1[2], v1[3]);
                    *(u32x4*)(rowp + bj * 128) = w; } }
    }
};

struct Args { const float* in[23]; float* out; unsigned char* ws; int ph_lo, ph_hi; };
enum { I_XP = 0, I_XS, I_CP, I_CS, I_WADA, I_BADA, I_WIN, I_RPB, I_SLNG, I_SLNB, I_WSP, I_BSP, I_WAUP, I_WSUP, I_WOUT, I_LN1G, I_LN1B, I_WFF1, I_BFF1, I_WFF2, I_BFF2, I_LN2G, I_LN2B };

__device__ __forceinline__ float wave_sum(float v) {
#pragma unroll
    for (int o = 1; o < 64; o <<= 1) v += __shfl_xor(v, o);
    return v;
}
__device__ __forceinline__ void transpose_item(const float* W, int K, int N, bf16_t* WT, int row_off, LAS float* scr, int kb, int nb, int lane) {
    const int k0 = 64 * kb, n0 = 32 * nb;
#pragma unroll 8
    for (int i = 0; i < 32; ++i) { const int kk = 2 * i + (lane >> 5); scr[kk * 33 + (lane & 31)] = W[(size_t)(k0 + kk) * N + n0 + (lane & 31)]; }
    asm volatile("s_waitcnt lgkmcnt(0)" ::: "memory");
    const int c = lane & 7;
#pragma unroll
    for (int j = 0; j < 4; ++j) { const int n = (lane >> 3) + 8 * j; const LAS float* s = scr + (8 * c) * 33 + n;
        u32x4 o; o.x = pk2(s[0 * 33], s[1 * 33]); o.y = pk2(s[2 * 33], s[3 * 33]); o.z = pk2(s[4 * 33], s[5 * 33]); o.w = pk2(s[6 * 33], s[7 * 33]);
        *(u32x4*)(WT + (size_t)(row_off + n0 + n) * K + k0 + 8 * c) = o; }
    asm volatile("s_waitcnt lgkmcnt(0)" ::: "memory");
}

__device__ __forceinline__ void p0_prep(const Args& a, LAS unsigned char* lds, int tid, int wave, int lane) {
    unsigned char* ws = a.ws;
    float* ADA = (float*)(ws + WS_ADA);
    if (blockIdx.x < 96) {
        LAS float* sc = (LAS float*)lds; LAS float* red = (LAS float*)(lds + 40960);
        for (int i = tid; i < 10240; i += 512) { const int b = i >> 10, k = i & 1023; const float c = b < 2 ? a.in[I_CP][b * 1024 + k] : a.in[I_CS][(b - 2) * 1024 + k]; sc[i] = c * __builtin_amdgcn_rcpf(1.0f + __expf(-c)); }
        __syncthreads();
        const int col = blockIdx.x * 64 + lane; const float* wp = a.in[I_WADA] + col;
        float acc[10];
#pragma unroll
        for (int b = 0; b < 10; ++b) acc[b] = 0.f;
#pragma unroll 4
        for (int k = wave * 128; k < wave * 128 + 128; ++k) { const float w = wp[(size_t)k * 6144];
#pragma unroll
            for (int b = 0; b < 10; ++b) acc[b] += sc[b * 1024 + k] * w; }
#pragma unroll
        for (int b = 0; b < 10; ++b) red[(wave * 10 + b) * 64 + lane] = acc[b];
        __syncthreads();
        for (int i = tid; i < 640; i += 512) { const int b = i >> 6, l = i & 63; float s = 0.f;
#pragma unroll
            for (int w = 0; w < 8; ++w) s += red[(w * 10 + b) * 64 + l];
            ADA[b * 6144 + blockIdx.x * 64 + l] = s + a.in[I_BADA][blockIdx.x * 64 + l]; }
        __syncthreads();
    }
    { bf16_t* WSB = (bf16_t*)(ws + WS_WSB); const float* w_s = a.in[I_WSP];
      for (int i = blockIdx.x * 512 + tid; i < 131072 / 2; i += gridDim.x * 512) { const f32x2v v = *(const f32x2v*)(w_s + 2 * i); *(unsigned*)(WSB + 2 * i) = pk2(v.x, v.y); } }
    LAS float* scr = (LAS float*)(lds + wave * 16384);
    const int gw = blockIdx.x * 8 + wave, NGW = gridDim.x * 8;
    constexpr int I_IN = 16 * 144, I_A = 8 * 32, I_S = 8 * 32, I_O = 16 * 32, I_1 = 16 * 128, I_2 = 64 * 32, NIT = I_IN + I_A + I_S + I_O + I_1 + I_2;
    for (int it = gw; it < NIT; it += NGW) {
        int r = it;
        if (r < I_IN) { const int kb = r / 144, nb = r % 144, n0 = nb * 32; const int ro = n0 < 1024 ? 0 : (n0 < 1536 ? 3072 : -512);
            transpose_item(a.in[I_WIN], 1024, 4608, (bf16_t*)(ws + WS_WIN), ro, scr, kb, nb, lane); continue; } r -= I_IN;
        if (r < I_A) { transpose_item(a.in[I_WAUP], 512, 1024, (bf16_t*)(ws + WS_WA), 0, scr, r / 32, r % 32, lane); continue; } r -= I_A;
        if (r < I_S) { transpose_item(a.in[I_WSUP], 512, 1024, (bf16_t*)(ws + WS_WS), 0, scr, r / 32, r % 32, lane); continue; } r -= I_S;
        if (r < I_O) { transpose_item(a.in[I_WOUT], 1024, 1024, (bf16_t*)(ws + WS_WO), 0, scr, r / 32, r % 32, lane); continue; } r -= I_O;
        if (r < I_1) { transpose_item(a.in[I_WFF1], 1024, 4096, (bf16_t*)(ws + WS_W1), 0, scr, r / 128, r % 128, lane); continue; } r -= I_1;
        transpose_item(a.in[I_WFF2], 4096, 1024, (bf16_t*)(ws + WS_W2), 0, scr, r / 32, r % 32, lane);
    }
}

__device__ __forceinline__ void modulate_rows(const float* X, bf16_t* H, const float* ada_shift, int bb0, int tsh, int gw, int ngw, int lane) {
    for (int row = gw; row < NTOK; row += ngw) {
        const float* sh = ada_shift + (size_t)(bb0 + (row >> tsh)) * 6144; const float* scl = sh + 1024;
        const f32x4* xr = (const f32x4*)(X + (size_t)row * D) + lane; u32x2* o = (u32x2*)(H + (size_t)row * D) + lane;
#pragma unroll
        for (int j = 0; j < 4; ++j) { const f32x4 v = xr[64 * j], s = ((const f32x4*)scl)[lane + 64 * j], t = ((const f32x4*)sh)[lane + 64 * j];
            const f32x4 h = v * (s + 1.0f) + t; u32x2 w; w.x = pk2(h[0], h[1]); w.y = pk2(h[2], h[3]); o[64 * j] = w; }
    }
}
__device__ __forceinline__ void ln_rows(float* Y, bf16_t* H2, const float* g, const float* b, const float* ada_shift, int bb0, int tsh, int gw, int ngw, int lane) {
    for (int row = gw; row < NTOK; row += ngw) {
        f32x4* yr = (f32x4*)(Y + (size_t)row * D) + lane;
        f32x4 v[4]; float s = 0.f;
#pragma unroll
        for (int j = 0; j < 4; ++j) { v[j] = yr[64 * j]; s += (v[j][0] + v[j][1]) + (v[j][2] + v[j][3]); }
        const float mean = wave_sum(s) * (1.f / D); float s2 = 0.f;
#pragma unroll
        for (int j = 0; j < 4; ++j) { v[j] = v[j] - mean; s2 += (v[j][0] * v[j][0] + v[j][1] * v[j][1]) + (v[j][2] * v[j][2] + v[j][3] * v[j][3]); }
        const float rstd = 1.0f / sqrtf(wave_sum(s2) * (1.f / D) + LN_EPS);
#pragma unroll
        for (int j = 0; j < 4; ++j) { v[j] = v[j] * rstd * ((const f32x4*)g)[lane + 64 * j] + ((const f32x4*)b)[lane + 64 * j]; yr[64 * j] = v[j]; }
        if (H2) { const float* sh = ada_shift + (size_t)(bb0 + (row >> tsh)) * 6144; const float* scl = sh + 1024; u32x2* o = (u32x2*)(H2 + (size_t)row * D) + lane;
#pragma unroll
            for (int j = 0; j < 4; ++j) { const f32x4 h = v[j] * (((const f32x4*)scl)[lane + 64 * j] + 1.0f) + ((const f32x4*)sh)[lane + 64 * j];
                u32x2 w; w.x = pk2(h[0], h[1]); w.y = pk2(h[2], h[3]); o[64 * j] = w; } }
    }
}

__device__ __forceinline__ void sgu_chunk(const bf16_t* UVS, const bf16_t* WSB, const float* lng, const float* lnb, const float* bsp, bf16_t* SGU, LAS unsigned char* lds, int chunk, int tid, int wave, int lane) {
    const int tok0 = chunk * 128;
    LAS f32x2v* stat = (LAS f32x2v*)(lds + LDS_STAT);
    { const int t = tid >> 2, part = tid & 3; const bf16_t* p = UVS + (size_t)(tok0 + t) * 1024 + 512 + part * 128; float s = 0.f, ss = 0.f;
#pragma unroll
      for (int i = 0; i < 16; ++i) { const u32x4 w = *(const u32x4*)(p + i * 8);
          const float e0 = bflo(w.x), e1 = bfhi(w.x), e2 = bflo(w.y), e3 = bfhi(w.y), e4 = bflo(w.z), e5 = bfhi(w.z), e6 = bflo(w.w), e7 = bfhi(w.w);
          s += ((e0 + e1) + (e2 + e3)) + ((e4 + e5) + (e6 + e7)); ss += ((e0 * e0 + e1 * e1) + (e2 * e2 + e3 * e3)) + ((e4 * e4 + e5 * e5) + (e6 * e6 + e7 * e7)); }
      s += __shfl_xor(s, 1); s += __shfl_xor(s, 2); ss += __shfl_xor(ss, 1); ss += __shfl_xor(ss, 2);
      const float mean = s * (1.f / 512.f), var = fmaxf(ss * (1.f / 512.f) - mean * mean, 0.f);
      if (part == 0) stat[t] = (f32x2v){mean, 1.0f / sqrtf(var + LN_EPS)}; }
    __syncthreads();
    const int g = wave, l15 = lane & 15, s4 = lane >> 4;
    LAS unsigned char* vt = lds + g * 16384;
#pragma unroll
    for (int hh = 0; hh < 2; ++hh) { const int t = lane + 64 * hh; const f32x2v st = stat[t]; const bf16_t* p = UVS + (size_t)(tok0 + t) * 1024 + 512 + g * 64;
#pragma unroll
        for (int c8 = 0; c8 < 8; ++c8) { const u32x4 w = *(const u32x4*)(p + c8 * 8); const unsigned ww[4] = {w.x, w.y, w.z, w.w};
#pragma unroll
            for (int e = 0; e < 8; ++e) { const int c = c8 * 8 + e; const float x = (e & 1) ? bfhi(ww[e >> 1]) : bflo(ww[e >> 1]);
                const float y = (x - st.x) * st.y * lng[g * 64 + c] + lnb[g * 64 + c];
                const int addr = c * 256 + ((((t >> 3) ^ (c & 15)) << 4) | ((t & 7) * 2));
                *(LAS bf16_t*)(vt + addr) = (bf16_t)(pk2(y, 0.f) & 0xffffu); } } }
    asm volatile("s_waitcnt lgkmcnt(0)" ::: "memory");
    bf16x8 af[4][4];
#pragma unroll
    for (int ct = 0; ct < 4; ++ct)
#pragma unroll
        for (int kk = 0; kk < 4; ++kk) af[ct][kk] = *(const LAS bf16x8*)(vt + (ct * 16 + l15) * 256 + (((kk * 4 + s4) ^ l15) << 4));
#pragma unroll 1
    for (int pt = 0; pt < 8; ++pt) {
        const bf16_t* wp = WSB + (size_t)(g * 128 + pt * 16 + l15) * 128 + s4 * 8;
        bf16x8 bf[4];
#pragma unroll
        for (int kk = 0; kk < 4; ++kk) bf[kk] = *(const bf16x8*)(wp + kk * 32);
        f32x4 acc[4];
#pragma unroll
        for (int ct = 0; ct < 4; ++ct) { acc[ct] = (f32x4){0.f, 0.f, 0.f, 0.f};
#pragma unroll
            for (int kk = 0; kk < 4; ++kk) acc[ct] = __builtin_amdgcn_mfma_f32_16x16x32_bf16(af[ct][kk], bf[kk], acc[ct], 0, 0, 0); }
        const int p = pt * 16 + l15; const float bias = bsp[g * 128 + p];
#pragma unroll
        for (int ct = 0; ct < 4; ++ct) { const int c = g * 64 + ct * 16 + s4 * 4;
            const u32x2 uu = *(const u32x2*)(UVS + (size_t)(tok0 + p) * 1024 + c);
            u32x2 w; w.x = pk2(bflo(uu.x) * (acc[ct][0] + bias), bfhi(uu.x) * (acc[ct][1] + bias)); w.y = pk2(bflo(uu.y) * (acc[ct][2] + bias), bfhi(uu.y) * (acc[ct][3] + bias));
            *(u32x2*)(SGU + (size_t)(tok0 + p) * 512 + c) = w; }
    }
    __syncthreads();
}

__device__ __forceinline__ void attn_item(const bf16_t* QK, const bf16_t* VT, bf16_t* ATT, const LAS float* rpb, int item, int rows_pb, int lane) {
    const int cb = item & 3, h = (item >> 2) & 7, R = item >> 5;
    const int b = R / rows_pb, r = R - b * rows_pb;
    int rs = r - 4; rs = rs < 0 ? 0 : (rs > rows_pb - 8 ? rows_pb - 8 : rs);
    const int kc0 = cb == 0 ? 0 : (cb == 1 ? 8 : (cb == 2 ? 24 : 32));
    const int l15 = lane & 15, s4 = lane >> 4;
    const int tq = R * 64 + cb * 16 + l15;
    const bf16_t* qp = QK + (size_t)tq * 1024 + h * 64 + s4 * 8;
    const bf16x8 qf0 = *(const bf16x8*)qp, qf1 = *(const bf16x8*)(qp + 32);
    const int krow0 = (b * rows_pb + rs) * 64;
    const bf16_t* kbase = QK + (size_t)(krow0 + kc0 + (l15 >> 2) * 8 + (l15 & 3)) * 1024 + 512 + h * 64 + s4 * 8;
    f32x4 sc[16];
#pragma unroll
    for (int i = 0; i < 8; ++i)
#pragma unroll
        for (int hf = 0; hf < 2; ++hf) { const bf16_t* kp = kbase + (size_t)(i * 64 + hf * 4) * 1024;
            const bf16x8 k0 = *(const bf16x8*)kp, k1 = *(const bf16x8*)(kp + 32);
            f32x4 z = (f32x4){0.f, 0.f, 0.f, 0.f};
            z = __builtin_amdgcn_mfma_f32_16x16x32_bf16(k0, qf0, z, 0, 0, 0); z = __builtin_amdgcn_mfma_f32_16x16x32_bf16(k1, qf1, z, 0, 0, 0); sc[i * 2 + hf] = z; }
    const int qc = cb * 16 + l15; int cs = qc - 8; cs = cs < 0 ? 0 : (cs > 48 ? 48 : cs);
    const LAS float* rp = rpb + h * 465 + (rs - r + 7) * 31;
    float mx = -3.0e38f;
#pragma unroll
    for (int i = 0; i < 8; ++i)
#pragma unroll
        for (int hf = 0; hf < 2; ++hf)
#pragma unroll
            for (int j = 0; j < 4; ++j) { const int kc = kc0 + s4 * 8 + hf * 4 + j; const bool valid = (kc >= cs) && (kc < cs + 16);
                int dc = kc - qc + 15; dc = dc < 0 ? 0 : (dc > 30 ? 30 : dc);
                const float v = valid ? sc[i * 2 + hf][j] + rp[i * 31 + dc] : -3.0e38f; sc[i * 2 + hf][j] = v; mx = fmaxf(mx, v); }
    mx = fmaxf(mx, __shfl_xor(mx, 16)); mx = fmaxf(mx, __shfl_xor(mx, 32));
    float sum = 0.f;
#pragma unroll
    for (int t = 0; t < 16; ++t)
#pragma unroll
        for (int j = 0; j < 4; ++j) { const float p = __builtin_amdgcn_exp2f((sc[t][j] - mx) * 1.4426950408889634f); sc[t][j] = p; sum += p; }
    sum += __shfl_xor(sum, 16); sum += __shfl_xor(sum, 32);
    const float inv = 1.0f / sum;
    f32x4 o[4];
#pragma unroll
    for (int dt = 0; dt < 4; ++dt) o[dt] = (f32x4){0.f, 0.f, 0.f, 0.f};
    const bf16_t* vbase = VT + (size_t)(h * 64 + l15) * NTOK + krow0 + kc0 + s4 * 8;
#pragma unroll
    for (int i = 0; i < 8; ++i) {
        u32x4 pw; pw.x = pk2(sc[2 * i][0], sc[2 * i][1]); pw.y = pk2(sc[2 * i][2], sc[2 * i][3]); pw.z = pk2(sc[2 * i + 1][0], sc[2 * i + 1][1]); pw.w = pk2(sc[2 * i + 1][2], sc[2 * i + 1][3]);
        const bf16x8 pf = __builtin_bit_cast(bf16x8, pw);
#pragma unroll
        for (int dt = 0; dt < 4; ++dt) { const bf16x8 vf = *(const bf16x8*)(vbase + (size_t)(dt * 16) * NTOK + i * 64);
            o[dt] = __builtin_amdgcn_mfma_f32_16x16x32_bf16(vf, pf, o[dt], 0, 0, 0); }
    }
    bf16_t* op = ATT + (size_t)tq * 512 + h * 64 + s4 * 4;
#pragma unroll
    for (int dt = 0; dt < 4; ++dt) { u32x2 w; w.x = pk2(o[dt][0] * inv, o[dt][1] * inv); w.y = pk2(o[dt][2] * inv, o[dt][3] * inv); *(u32x2*)(op + dt * 16) = w; }
}

#ifdef ONLY_SUB
#define EN(k) ((k) == ONLY_SUB)
#else
#define EN(k) true
#endif
__global__ void __launch_bounds__(512, 2) mk_fwd(Args a) {
    extern __shared__ __attribute__((aligned(16))) unsigned char lds_raw[];
    LAS unsigned char* lds = (LAS unsigned char*)lds_raw;
    cg::grid_group grid = cg::this_grid();
#pragma unroll 1
    for (int ph = a.ph_lo; ph < a.ph_hi; ++ph) {
    int tid_l = threadIdx.x; asm volatile("" : "+v"(tid_l)); const int tid = tid_l, lane = tid & 63, wave = __builtin_amdgcn_readfirstlane(tid >> 6);
    const int G = gridDim.x, gw = blockIdx.x * 8 + wave, ngw = G * 8;
    unsigned char* ws = a.ws; asm volatile("" : "+s"(ws));
    const float* ADA = (const float*)(ws + WS_ADA);
    bf16_t* H = (bf16_t*)(ws + WS_H); bf16_t* Z = (bf16_t*)(ws + WS_Z); bf16_t* VT = (bf16_t*)(ws + WS_VT); bf16_t* ATT = (bf16_t*)(ws + WS_ATT); bf16_t* SGU = (bf16_t*)(ws + WS_SGU);
    bf16_t* QK = Z; bf16_t* UVS = Z + (size_t)NTOK * 1024; bf16_t* GA = Z + (size_t)2 * NTOK * 1024; bf16_t* GB = Z + (size_t)3 * NTOK * 1024;
    const bf16_t* WinT = (const bf16_t*)(ws + WS_WIN); const bf16_t* WaT = (const bf16_t*)(ws + WS_WA); const bf16_t* WsT = (const bf16_t*)(ws + WS_WS);
    const bf16_t* WoT = (const bf16_t*)(ws + WS_WO); const bf16_t* W1T = (const bf16_t*)(ws + WS_W1); const bf16_t* W2T = (const bf16_t*)(ws + WS_W2);
        if (ph == 0 && EN(-1)) { p0_prep(a, lds, tid, wave, lane); }
        else {
            const int ck = (ph - 1) / 9, sub = (ph - 1) % 9;
            const float* X = ck == 0 ? a.in[I_XP] : a.in[I_XS]; float* OUT = a.out + (size_t)ck * NTOK * D;
            const int bb0 = ck == 0 ? 0 : 2, tsh = ck == 0 ? 14 : 12, bsh = tsh - 8, rows_pb = ck == 0 ? 256 : 64;
            if (sub == 0 && EN(0)) { modulate_rows(X, H, ADA, bb0, tsh, gw, ngw, lane); }
            else if (sub == 1 && EN(1)) {
                { pg8::Gemm g{H, WinT, NTOK, 4096, 1024}; pg8::StaticOrder S; S.init(NTOK, 4096, G, (int)blockIdx.x); EpiZ E{Z};
                  pg8::gemm_phase<EpiZ, pg8::StaticOrder, false>(lds, g, S, E, nullptr); }
                { pg8::Gemm g{WinT + (size_t)4096 * 1024, H, 512, NTOK, 1024}; pg8::StaticOrder S; S.init(512, NTOK, G, (int)blockIdx.x); EpiPlain E{VT, NTOK};
                  pg8::gemm_phase<EpiPlain, pg8::StaticOrder, false>(lds, g, S, E, nullptr); }
            }
            else if (sub == 2 && EN(2)) {
                LAS float* rpb = (LAS float*)(lds + LDS_RPB);
                for (int i = tid; i < 3720; i += 512) rpb[i] = a.in[I_RPB][i];
                for (int ch = blockIdx.x; ch < NTOK / 128; ch += G)
                    sgu_chunk(UVS, (const bf16_t*)(ws + WS_WSB), a.in[I_SLNG], a.in[I_SLNB], a.in[I_BSP], SGU, lds, ch, tid, wave, lane);
                __syncthreads();
                for (int it = gw; it < (NTOK / 16) * 8; it += ngw) attn_item(QK, VT, ATT, rpb, it, rows_pb, lane);
            }
            else if (sub == 3 && EN(3)) {
                { pg8::Gemm g{ATT, WaT, NTOK, 1024, 512}; pg8::StaticOrder S; S.init(NTOK, 1024, G, (int)blockIdx.x); EpiGate<0> E{GA, H};
                  pg8::gemm_phase<EpiGate<0>, pg8::StaticOrder, false>(lds, g, S, E, nullptr); }
                { pg8::Gemm g{SGU, WsT, NTOK, 1024, 512}; pg8::StaticOrder S; S.init(NTOK, 1024, G, (int)blockIdx.x); EpiGate<1> E{GB, H};
                  pg8::gemm_phase<EpiGate<1>, pg8::StaticOrder, false>(lds, g, S, E, nullptr); }
            }
            else if (sub == 4 && EN(4)) { pg8::Gemm g{H, WoT, NTOK, 1024, 1024}; pg8::StaticOrder S; S.init(NTOK, 1024, G, (int)blockIdx.x); EpiRes E{X, OUT, ADA + 2 * 1024, nullptr, bb0, bsh};
                pg8::gemm_phase<EpiRes, pg8::StaticOrder, false>(lds, g, S, E, nullptr); }
            else if (sub == 5 && EN(5)) { ln_rows(OUT, H, a.in[I_LN1G], a.in[I_LN1B], ADA + 3 * 1024, bb0, tsh, gw, ngw, lane); }
            else if (sub == 6 && EN(6)) { pg8::Gemm g{H, W1T, NTOK, 4096, 1024}; pg8::StaticOrder S; S.init(NTOK, 4096, G, (int)blockIdx.x); EpiFF1 E{Z, a.in[I_BFF1]};
                pg8::gemm_phase<EpiFF1, pg8::StaticOrder, false>(lds, g, S, E, nullptr); }
            else if (sub == 7 && EN(7)) { pg8::Gemm g{Z, W2T, NTOK, 1024, 4096}; pg8::StaticOrder S; S.init(NTOK, 1024, G, (int)blockIdx.x); EpiRes E{OUT, OUT, ADA + 5 * 1024, a.in[I_BFF2], bb0, bsh};
                pg8::gemm_phase<EpiRes, pg8::StaticOrder, false>(lds, g, S, E, nullptr); }
            else if (EN(8)) { ln_rows(OUT, nullptr, a.in[I_LN2G], a.in[I_LN2B], ADA, bb0, tsh, gw, ngw, lane); }
        }
        if (ph + 1 < a.ph_hi) { __threadfence(); grid.sync(); }
    }
}

extern "C" void kernel_launch(void* const* d_in, const int* in_sizes, int n_in, void* d_out, int out_size, void* d_ws, size_t ws_size, hipStream_t stream) {
    static int grid = 0;
    if (grid == 0) {
        if (n_in != 23 || ws_size < WS_END) { fprintf(stderr, "kernel_launch: n_in %d ws %zu (need %zu)\n", n_in, ws_size, (size_t)WS_END); grid = -1; return; }
        int dev = 0, cus = 0, per_cu = 0;
        hipGetDevice(&dev); hipDeviceGetAttribute(&cus, hipDeviceAttributeMultiprocessorCount, dev);
        if (hipFuncSetAttribute((const void*)mk_fwd, hipFuncAttributeMaxDynamicSharedMemorySize, LDS_BYTES) != hipSuccess) { fprintf(stderr, "kernel_launch: hipFuncSetAttribute failed\n"); grid = -1; return; }
        hipOccupancyMaxActiveBlocksPerMultiprocessor(&per_cu, (const void*)mk_fwd, 512, LDS_BYTES);
        (void)hipGetLastError();
        if (per_cu < 1) fprintf(stderr, "kernel_launch: occupancy query says %d blocks per CU\n", per_cu);
        grid = cus > 0 ? cus : 256;
    }
    if (grid < 0) return;
    Args a{};
    for (int i = 0; i < 23; ++i) a.in[i] = (const float*)d_in[i];
    a.out = (float*)d_out; a.ws = (unsigned char*)d_ws;
#if MK_MULTI
    for (int ph = 0; ph < NPH; ++ph) { a.ph_lo = ph; a.ph_hi = ph + 1; hipLaunchKernelGGL(mk_fwd, dim3(grid), dim3(512), LDS_BYTES, stream, a); }
#else
    a.ph_lo = 0; a.ph_hi = NPH;
    void* args[] = {&a};
    hipError_t e = hipLaunchCooperativeKernel((const void*)mk_fwd, dim3(grid), dim3(512), args, LDS_BYTES, stream);
    if (e != hipSuccess) fprintf(stderr, "cooperative launch failed: %s (grid %d)\n", hipGetErrorString(e), grid);
#endif
}
```

```cpp
#include <hip/hip_runtime.h>
#include <hip/hip_cooperative_groups.h>
#include <cstdio>
namespace cg = cooperative_groups;
#ifndef MK_MULTI
#define MK_MULTI 0
#endif
namespace pg8 {
#define PG8_LAS __attribute__((address_space(3)))
typedef unsigned short bf16_t;
typedef short bf16x8 __attribute__((ext_vector_type(8)));
typedef float f32x4 __attribute__((ext_vector_type(4)));
typedef unsigned u32x4 __attribute__((ext_vector_type(4)));
constexpr int BM = 256, BK = 64, HALF = 128, HTB = HALF * BK * 2  , STAGE_BYTES = 8 * HTB, NXCD = 8, WGM = 8;

__host__ __device__ __forceinline__ int lds_byte(int r, int c) { const int st = (r >> 4) * 2 + (c >> 5), rr = r & 15, cc = c & 31, ob = rr * 64 + cc * 2; return st * 1024 + (ob ^ (((ob >> 9) & 1) << 5)); }
__host__ __device__ __forceinline__ void stage_rc(int b, int& R, int& C) { const int st = b / 1024, sb = b % 1024, swz = sb ^ (((sb >> 9) & 1) << 5); R = (st >> 1) * 16 + swz / 64; C = (st & 1) * 32 + (swz % 64) / 2; }
__host__ __device__ __forceinline__ int perm32(int rho) { const int n = rho >> 4, i = rho & 15; return 8 * (i >> 2) + 4 * n + (i & 3); }

struct Unit { int pm, pn; };
struct Gemm { const bf16_t* A; const bf16_t* Bt; int M, N, K; };

struct StaticOrder {
    int nM, nN, nwg, G, c;
    __host__ __device__ void init(int M, int N, int G_, int c_) { nM = M / BM; nN = N / BM; nwg = nM * nN; G = G_; c = c_; }
    __host__ __device__ bool next(int i, Unit& u) const {
        const long L = (long)i * G + c; if (L >= nwg) return false;
        int wgid = (int)L; { const int q = nwg / NXCD, r = nwg % NXCD, xcd = wgid % NXCD, off = wgid / NXCD; wgid = (xcd < r ? xcd * (q + 1) : r * (q + 1) + (xcd - r) * q) + off; }
        const int nig = WGM * nN, gid = wgid / nig, fm = gid * WGM, gsz = (nM - fm) < WGM ? (nM - fm) : WGM;
        u.pm = fm + ((wgid % nig) % gsz); u.pn = (wgid % nig) / gsz; return true;
    }
    __device__ __forceinline__ void a_ready(const Unit&) const {}
    __device__ __forceinline__ void done(const Unit&) const {}
};
__device__ __forceinline__ unsigned cvt_pk_bf16(float lo, float hi) { unsigned r; asm volatile("v_cvt_pk_bf16_f32 %0, %1, %2" : "=v"(r) : "v"(lo), "v"(hi)); return r; }
typedef float f32x2 __attribute__((ext_vector_type(2)));
__device__ __forceinline__ f32x2 gelu_pk(f32x2 v) {
    const f32x2 av = __builtin_elementwise_abs(v), d = av * 0.2316418882f + 1.0f;
    f32x2 t; t.x = __builtin_amdgcn_rcpf(d.x); t.y = __builtin_amdgcn_rcpf(d.y);
    f32x2 q = t * 0.5307027145f + (-0.7265760135f); q = q * t + 0.7107068705f; q = q * t + (-0.142248368f); q = q * t + 0.127414796f; q = q * t;
    const f32x2 s = (v * v) * (-0.72134752044f);
    f32x2 e; e.x = __builtin_amdgcn_exp2f(s.x); e.y = __builtin_amdgcn_exp2f(s.y);
    const f32x2 m = v * (q * e), r = v - m;
    f32x2 o; o.x = v.x < 0.f ? m.x : r.x; o.y = v.y < 0.f ? m.y : r.y; return o;
}
template <class Epi, class Sched, bool STAMP = false>
__device__ __forceinline__ void gemm_phase(PG8_LAS unsigned char* lds, const Gemm g, const Sched& S, const Epi& E, unsigned long long* stamps) {
    int tid_l = threadIdx.x; asm volatile("" : "+v"(tid_l)); const int tid = tid_l, wid = __builtin_amdgcn_readfirstlane(tid >> 6), lane = tid & 63, wr = wid >> 2, wc = wid & 3, fr = lane & 15, fq = lane >> 4;
    const int K = g.K, nt = K / BK;
    int ts_lo = 0, ts_hi = 0, nts = 0; const unsigned long long rt_entry = STAMP ? (unsigned long long)wall_clock64() : 0ull;
#define PG8_STAMP() do { if (STAMP && wid == 0 && nts < 64) { const unsigned long long _c = (unsigned long long)clock64(); \
        ts_lo = (lane == nts) ? (int)(unsigned)_c : ts_lo; ts_hi = (lane == nts) ? (int)(unsigned)(_c >> 32) : ts_hi; ++nts; } } while (0)
    PG8_STAMP();
    unsigned voffA[2], voffB[2];
#pragma unroll
    for (int i = 0; i < 2; ++i) { int R, C; stage_rc(tid * 16 + i * 8192, R, C); const int Rb = Epi::PERM ? ((R & ~31) + perm32(R & 31)) : R;
        voffA[i] = (unsigned)(R * K + C) * 2u; voffB[i] = (unsigned)(Rb * K + C) * 2u; }
    const size_t kstep = (size_t)(BK * 2);
    const size_t hstep = (size_t)HALF * K * 2;
    const size_t tstep = 2 * hstep;
    const unsigned ldsw = (unsigned)wid * 1024u;
    const int aoff = lds_byte(wr * 64 + fr, fq * 8), boff = lds_byte(wc * 32 + fr, fq * 8);
#define PG8_SA(b, h) (((b) * 2 + (h)) * HTB)
#define PG8_SB(b, h) ((4 + (b) * 2 + (h)) * HTB)
#define PG8_STAGE(bufoff, gbase, voff) do { _Pragma("unroll") for (int _i = 0; _i < 2; ++_i) \
        __builtin_amdgcn_global_load_lds((const unsigned*)((const char*)(gbase) + (voff)[_i]), (PG8_LAS unsigned*)(lds + (bufoff) + ldsw + _i * 8192), 16, 0, 0); } while (0)
#define PG8_LDA(dst, b, h) do { _Pragma("unroll") for (int m = 0; m < 4; ++m) _Pragma("unroll") for (int k = 0; k < 2; ++k) dst[m][k] = *(const PG8_LAS bf16x8*)(lds + PG8_SA(b, h) + aoff + m * 2048 + k * 1024); } while (0)
#define PG8_LDB(dst, b, h) do { _Pragma("unroll") for (int n = 0; n < 2; ++n) _Pragma("unroll") for (int k = 0; k < 2; ++k) dst[n][k] = *(const PG8_LAS bf16x8*)(lds + PG8_SB(b, h) + boff + n * 2048 + k * 1024); } while (0)
#define PG8_MMA(ai, bj, At, Bt) do { __builtin_amdgcn_s_setprio(1); _Pragma("unroll") for (int m = 0; m < 4; ++m) _Pragma("unroll") for (int n = 0; n < 2; ++n) _Pragma("unroll") for (int k = 0; k < 2; ++k) \
        acc[ai][bj][m][n] = __builtin_amdgcn_mfma_f32_16x16x32_bf16(Bt[n][k], At[m][k], acc[ai][bj][m][n], 0, 0, 0); __builtin_amdgcn_s_setprio(0); } while (0)
#define PG8_WAIT_V(n) asm volatile("s_waitcnt vmcnt(" #n ")" ::: "memory")
#define PG8_WAIT_L(n) asm volatile("s_waitcnt lgkmcnt(" #n ")" ::: "memory")
#define PG8_BAR __builtin_amdgcn_s_barrier()
#define PG8_SCHED __builtin_amdgcn_sched_barrier(0)
    Unit cur, nxt; int ui = 0;
    if (!S.next(0, cur)) return;
    f32x4 acc[2][2][4][2];
#pragma unroll
    for (int a = 0; a < 2; ++a)
#pragma unroll
        for (int b = 0; b < 2; ++b)
#pragma unroll
            for (int m = 0; m < 4; ++m)
#pragma unroll
                for (int n = 0; n < 2; ++n) acc[a][b][m][n] = (f32x4){0.f, 0.f, 0.f, 0.f};
    bf16x8 At[4][2], B0[2][2], B1[2][2];
    const char* cA = (const char*)g.A + (size_t)cur.pm * tstep; const char* cB = (const char*)g.Bt + (size_t)cur.pn * tstep;
    S.a_ready(cur);
    PG8_STAGE(PG8_SB(0, 0), cB, voffB); PG8_STAGE(PG8_SA(0, 0), cA, voffA); PG8_STAGE(PG8_SB(0, 1), cB + hstep, voffB); PG8_STAGE(PG8_SA(0, 1), cA + hstep, voffA);
    if (wr == 1) PG8_BAR;
    PG8_WAIT_V(4); PG8_BAR;
    PG8_STAGE(PG8_SB(1, 0), cB + kstep, voffB); PG8_STAGE(PG8_SA(1, 0), cA + kstep, voffA); PG8_STAGE(PG8_SB(1, 1), cB + hstep + kstep, voffB);
    PG8_WAIT_V(6); PG8_BAR;
    PG8_STAMP();
    for (;;) {
        const bool has_next = S.next(ui + 1, nxt);
        const char* nA = has_next ? (const char*)g.A + (size_t)nxt.pm * tstep : cA; const char* nB = has_next ? (const char*)g.Bt + (size_t)nxt.pn * tstep : cB;
        for (int t = 0; t < nt; t += 2) {
            const bool last = (t == nt - 2);
            const char* a1 = cA + (size_t)(t + 1) * kstep;
            const char* a2 = last ? nA : cA + (size_t)(t + 2) * kstep; const char* b2 = last ? nB : cB + (size_t)(t + 2) * kstep;
            const char* a3 = a2 + kstep; const char* b3 = b2 + kstep;
            if (last && has_next) S.a_ready(nxt);
            PG8_LDB(B0, 0, 0); PG8_SCHED; PG8_LDA(At, 0, 0); PG8_STAGE(PG8_SA(1, 1), a1 + hstep, voffA);
            PG8_WAIT_L(8); PG8_BAR; PG8_WAIT_L(0); PG8_MMA(0, 0, At, B0); PG8_BAR; PG8_SCHED;
            PG8_LDB(B1, 0, 1); PG8_STAGE(PG8_SB(0, 0), b2, voffB);
            PG8_BAR; PG8_WAIT_L(0); PG8_MMA(0, 1, At, B1); PG8_BAR;
            PG8_LDA(At, 0, 1); PG8_STAGE(PG8_SA(0, 0), a2, voffA);
            PG8_BAR; PG8_WAIT_L(0); PG8_MMA(1, 0, At, B0); PG8_BAR; PG8_SCHED;
            PG8_STAGE(PG8_SB(0, 1), b2 + hstep, voffB);
            PG8_WAIT_V(6); PG8_BAR; PG8_MMA(1, 1, At, B1); PG8_BAR;
            PG8_LDB(B0, 1, 0); PG8_SCHED; PG8_LDA(At, 1, 0); PG8_STAGE(PG8_SA(0, 1), a2 + hstep, voffA);
            PG8_WAIT_L(8); PG8_BAR; PG8_WAIT_L(0); PG8_MMA(0, 0, At, B0); PG8_BAR; PG8_SCHED;
            PG8_LDB(B1, 1, 1); PG8_STAGE(PG8_SB(1, 0), b3, voffB);
            PG8_BAR; PG8_WAIT_L(0); PG8_MMA(0, 1, At, B1); PG8_BAR;
            PG8_LDA(At, 1, 1); PG8_STAGE(PG8_SA(1, 0), a3, voffA);
            PG8_BAR; PG8_WAIT_L(0); PG8_MMA(1, 0, At, B0); PG8_BAR; PG8_SCHED;
            PG8_STAGE(PG8_SB(1, 1), b3 + hstep, voffB);
            PG8_WAIT_V(6); PG8_BAR; PG8_MMA(1, 1, At, B1); PG8_BAR;
        }
        PG8_STAMP();
        if constexpr (!Epi::AFTER_DRAIN) { E(acc, cur, wr, wc, fr, fq); S.done(cur); }
        PG8_STAMP();
        if (!has_next) break;
#pragma unroll
        for (int a = 0; a < 2; ++a)
#pragma unroll
            for (int b = 0; b < 2; ++b)
#pragma unroll
                for (int m = 0; m < 4; ++m)
#pragma unroll
                    for (int n = 0; n < 2; ++n) acc[a][b][m][n] = (f32x4){0.f, 0.f, 0.f, 0.f};
        cur = nxt; cA = nA; cB = nB; ++ui;
    }
    PG8_WAIT_V(0);
    if (wr == 0) PG8_BAR;
    PG8_BAR;
    if constexpr (Epi::AFTER_DRAIN) { E.fused(acc, cur, wr, wc, fr, fq, lds, wid, lane); S.done(cur); }
    PG8_STAMP();
    if (STAMP && wid == 0) { stamps[lane] = lane < nts ? (((unsigned long long)(unsigned)ts_hi << 32) | (unsigned)ts_lo) : 0ull;
        if (lane == 62) stamps[62] = rt_entry; if (lane == 63) stamps[63] = (unsigned long long)wall_clock64(); }
#undef PG8_STAMP
#undef PG8_SA
#undef PG8_SB
#undef PG8_STAGE
#undef PG8_LDA
#undef PG8_LDB
#undef PG8_MMA
#undef PG8_WAIT_V
#undef PG8_WAIT_L
#undef PG8_BAR
#undef PG8_SCHED
}
}
#define LAS __attribute__((address_space(3)))
#define XB_TMO      128
#define XB_XCNT(j)  (256  + 64 * (j))
#define XB_XSUB(j)  (1280 + 64 * (j))
#define XB_XGEN(j)  (2304 + 64 * (j))
#define XB_TOP      3328
#define XB_TOPGEN   3392
#define XCD_BAR_WORDS 3456
#define XB_SPIN_CAP (1u << 18)

__device__ __forceinline__ unsigned xb_ld(unsigned* p)              { return __hip_atomic_load(p, __ATOMIC_RELAXED, __HIP_MEMORY_SCOPE_AGENT); }
__device__ __forceinline__ unsigned xb_add(unsigned* p, unsigned v) { return __hip_atomic_fetch_add(p, v, __ATOMIC_RELAXED, __HIP_MEMORY_SCOPE_AGENT); }
__device__ __forceinline__ unsigned xb_xcc_id() { return (unsigned)__builtin_amdgcn_s_getreg((3 << 11) | 20) & 0xFu; }
#define XB_SPIN(cond, bar) do { unsigned _sp = 0; while (cond) { __builtin_amdgcn_s_sleep(1); \
    if ((++_sp & 255u) == 0u) { if (xb_ld(&(bar)[XB_TMO])) break; if (_sp > XB_SPIN_CAP) { atomicAdd(&(bar)[XB_TMO], 1u); break; } } } } while (0)

struct XcdBarrier {
    unsigned* bar; unsigned x;
    volatile LAS unsigned* st;
};

__device__ __forceinline__ XcdBarrier xcd_barrier_post(unsigned* bar, volatile LAS unsigned* st) {
    XcdBarrier b; b.bar = bar; b.x = xb_xcc_id(); b.st = st;
    if (threadIdx.x == 0) (void)xb_add(&bar[XB_XCNT(b.x)], 1u);
    return b;
}
__device__ __forceinline__ void xcd_barrier_complete(unsigned* bar, unsigned x, unsigned& nloc, unsigned& nx) {
    const unsigned G = gridDim.x * gridDim.y * gridDim.z;
    unsigned sum, cnt, mine, sp = 0u;
    for (;;) {
        sum = 0u; cnt = 0u; mine = 0u;
#pragma unroll
        for (unsigned j = 0; j < 16; ++j) { const unsigned c = xb_ld(&bar[XB_XCNT(j)]); sum += c; cnt += (c > 0u) ? 1u : 0u; mine = (j == x) ? c : mine; }
        if (sum == G) break;
        __builtin_amdgcn_s_sleep(1);
        if ((++sp & 255u) == 0u) { if (xb_ld(&bar[XB_TMO])) break; if (sp > XB_SPIN_CAP) { atomicAdd(&bar[XB_TMO], 1u); break; } }
    }
    nloc = mine > 0u ? mine : 1u; nx = cnt > 0u ? cnt : 1u;
}

__device__ __forceinline__ void xcd_barrier(const XcdBarrier& b) {
    asm volatile("s_waitcnt vmcnt(0)" ::: "memory");
    __syncthreads();
    if (threadIdx.x == 0) {
        unsigned* bar = b.bar;
        __builtin_amdgcn_s_waitcnt(0);
        unsigned nloc = b.st[0], nx = b.st[1];
        if (nloc == 0u) { xcd_barrier_complete(bar, b.x, nloc, nx); b.st[0] = nloc; b.st[1] = nx; }
        const unsigned old = xb_add(&bar[XB_XSUB(b.x)], 1u);
        const unsigned gen = old / nloc;
        if (old + 1u == (gen + 1u) * nloc) {
            __builtin_amdgcn_fence(__ATOMIC_RELEASE, "agent");
            asm volatile("s_waitcnt vmcnt(0)" ::: "memory");
            const unsigned og = xb_add(&bar[XB_TOP], 1u);
            const unsigned tg = og / nx;
            if (og + 1u == (tg + 1u) * nx) xb_add(&bar[XB_TOPGEN], 1u);
            else XB_SPIN(xb_ld(&bar[XB_TOPGEN]) == tg, bar);
            __builtin_amdgcn_fence(__ATOMIC_ACQUIRE, "agent");
            xb_add(&bar[XB_XGEN(b.x)], 1u);
            asm volatile("s_waitcnt vmcnt(0)" ::: "memory");
        } else {
            XB_SPIN(xb_ld(&bar[XB_XGEN(b.x)]) == gen, bar);
            __builtin_amdgcn_fence(__ATOMIC_ACQUIRE, "agent");
            asm volatile("s_waitcnt vmcnt(0)" ::: "memory");
        }
    }
    __syncthreads();
}
typedef unsigned short bf16_t;
using pg8::bf16x8; using pg8::f32x4; using pg8::u32x4;
typedef unsigned u32x2 __attribute__((ext_vector_type(2)));
typedef float f32x2v __attribute__((ext_vector_type(2)));

constexpr int D = 1024, DFF = 4096, NTOK = 32768, NPH = 19;
constexpr float ALPHA = 1.189207115002721f, LN_EPS = 1e-5f;
constexpr int LDS_BYTES = 147456, LDS_STAT = 131072, LDS_RPB = 132096;
constexpr size_t MiB = 1048576;
constexpr size_t WS_ADA = 0, WS_WSB = 262144, WS_WIN = 524288, WS_WA = WS_WIN + 9 * MiB, WS_WS = WS_WA + MiB, WS_WO = WS_WS + MiB, WS_W1 = WS_WO + 2 * MiB,
                 WS_W2 = WS_W1 + 8 * MiB, WS_H = 30 * MiB, WS_Z = WS_H + 64 * MiB, WS_VT = WS_Z + 256 * MiB, WS_ATT = WS_VT + 32 * MiB, WS_SGU = WS_ATT + 32 * MiB,
                 WS_END = WS_SGU + 32 * MiB;

__device__ __forceinline__ unsigned pk2(float lo, float hi) { return pg8::cvt_pk_bf16(lo, hi); }
__device__ __forceinline__ float bflo(unsigned w) { return __uint_as_float(w << 16); }
__device__ __forceinline__ float bfhi(unsigned w) { return __uint_as_float(w & 0xffff0000u); }
__device__ __forceinline__ float sigmoidf_(float x) { return __builtin_amdgcn_rcpf(1.0f + __expf(-x)); }
__device__ __forceinline__ float gelu_tanh(float x) { const float t = x * (1.5957691216057308f + 0.07135481627260025f * x * x); return x * __builtin_amdgcn_rcpf(1.0f + __expf(-t)); }

struct EpiZ {
    static constexpr bool PERM = true, AFTER_DRAIN = false;
    bf16_t* O;
    __device__ __forceinline__ void operator()(const f32x4 (&acc)[2][2][4][2], const pg8::Unit& u, int wr, int wc, int fr, int fq) const {
        const int row0 = u.pm * 256 + wr * 64 + fr;
        bf16_t* base = O + (size_t)(u.pn >> 2) * ((size_t)NTOK * 1024) + ((u.pn & 3) * 256 + wc * 32 + 8 * fq);
        const int mode = u.pn < 2 ? 0 : (u.pn < 4 ? 1 : (u.pn < 8 ? 2 : 3));
#pragma unroll
        for (int ai = 0; ai < 2; ++ai)
#pragma unroll
            for (int m = 0; m < 4; ++m) { bf16_t* rowp = base + (size_t)(row0 + ai * 128 + m * 16) * 1024;
#pragma unroll
                for (int bj = 0; bj < 2; ++bj) { f32x4 v0 = acc[ai][bj][m][0], v1 = acc[ai][bj][m][1];
                    if (mode == 0) { v0 *= 0.125f; v1 *= 0.125f; }
                    else if (mode == 2) {
#pragma unroll
                        for (int j = 0; j < 4; ++j) { v0[j] = gelu_tanh(v0[j]); v1[j] = gelu_tanh(v1[j]); } }
                    else if (mode == 3) {
#pragma unroll
                        for (int j = 0; j < 4; ++j) { v0[j] = sigmoidf_(v0[j]); v1[j] = sigmoidf_(v1[j]); } }
                    u32x4 w; w.x = pk2(v0[0], v0[1]); w.y = pk2(v0[2], v0[3]); w.z = pk2(v1[0], v1[1]); w.w = pk2(v1[2], v1[3]);
                    *(u32x4*)(rowp + bj * 128) = w; } }
    }
};
struct EpiPlain {
    static constexpr bool PERM = true, AFTER_DRAIN = false;
    bf16_t* O; int ldc;
    __device__ __forceinline__ void operator()(const f32x4 (&acc)[2][2][4][2], const pg8::Unit& u, int wr, int wc, int fr, int fq) const {
        const int row0 = u.pm * 256 + wr * 64 + fr, col0 = u.pn * 256 + wc * 32 + 8 * fq;
#pragma unroll
        for (int ai = 0; ai < 2; ++ai)
#pragma unroll
            for (int m = 0; m < 4; ++m) { bf16_t* rowp = O + (size_t)(row0 + ai * 128 + m * 16) * ldc + col0;
#pragma unroll
                for (int bj = 0; bj < 2; ++bj) { const f32x4 v0 = acc[ai][bj][m][0], v1 = acc[ai][bj][m][1];
                    u32x4 w; w.x = pk2(v0[0], v0[1]); w.y = pk2(v0[2], v0[3]); w.z = pk2(v1[0], v1[1]); w.w = pk2(v1[2], v1[3]);
                    *(u32x4*)(rowp + bj * 128) = w; } }
    }
};
template <int STEP> struct EpiGate {
    static constexpr bool PERM = true, AFTER_DRAIN = false;
    const bf16_t* G; bf16_t* O;
    __device__ __forceinline__ void operator()(const f32x4 (&acc)[2][2][4][2], const pg8::Unit& u, int wr, int wc, int fr, int fq) const {
        const int row0 = u.pm * 256 + wr * 64 + fr, col0 = u.pn * 256 + wc * 32 + 8 * fq;
#pragma unroll
        for (int ai = 0; ai < 2; ++ai)
#pragma unroll
            for (int m = 0; m < 4; ++m) { const size_t off = (size_t)(row0 + ai * 128 + m * 16) * 1024 + col0;
#pragma unroll
                for (int bj = 0; bj < 2; ++bj) { const f32x4 v0 = acc[ai][bj][m][0], v1 = acc[ai][bj][m][1];
                    const u32x4 g = *(const u32x4*)(G + off + bj * 128);
                    float o0 = bflo(g.x) * v0[0], o1 = bfhi(g.x) * v0[1], o2 = bflo(g.y) * v0[2], o3 = bfhi(g.y) * v0[3];
                    float o4 = bflo(g.z) * v1[0], o5 = bfhi(g.z) * v1[1], o6 = bflo(g.w) * v1[2], o7 = bfhi(g.w) * v1[3];
                    if (STEP == 1) { const u32x4 p = *(const u32x4*)(O + off + bj * 128);
                        o0 += bflo(p.x); o1 += bfhi(p.x); o2 += bflo(p.y); o3 += bfhi(p.y); o4 += bflo(p.z); o5 += bfhi(p.z); o6 += bflo(p.w); o7 += bfhi(p.w); }
                    u32x4 w; w.x = pk2(o0, o1); w.y = pk2(o2, o3); w.z = pk2(o4, o5); w.w = pk2(o6, o7);
                    *(u32x4*)(O + off + bj * 128) = w; } }
    }
};
struct EpiRes {
    static constexpr bool PERM = false, AFTER_DRAIN = false;
    const float* X; float* Y; const float* ada_gate; const float* bias; int bb0, bsh;
    __device__ __forceinline__ void operator()(const f32x4 (&acc)[2][2][4][2], const pg8::Unit& u, int wr, int wc, int fr, int fq) const {
        const int row0 = u.pm * 256 + wr * 64 + fr, col0 = u.pn * 256 + wc * 32 + 4 * fq;
        const float* gp = ada_gate + (size_t)(bb0 + (u.pm >> bsh)) * 6144 + col0;
        f32x4 gv[2][2], bv[2][2];
#pragma unroll
        for (int bj = 0; bj < 2; ++bj)
#pragma unroll
            for (int n = 0; n < 2; ++n) { gv[bj][n] = *(const f32x4*)(gp + bj * 128 + n * 16); bv[bj][n] = bias ? *(const f32x4*)(bias + col0 + bj * 128 + n * 16) : (f32x4){0.f, 0.f, 0.f, 0.f}; }
#pragma unroll
        for (int ai = 0; ai < 2; ++ai)
#pragma unroll
            for (int m = 0; m < 4; ++m) { const size_t off = (size_t)(row0 + ai * 128 + m * 16) * 1024 + col0;
#pragma unroll
                for (int bj = 0; bj < 2; ++bj)
#pragma unroll
                    for (int n = 0; n < 2; ++n) { const f32x4 x = *(const f32x4*)(X + off + bj * 128 + n * 16);
                        *(f32x4*)(Y + off + bj * 128 + n * 16) = x * ALPHA + gv[bj][n] * (acc[ai][bj][m][n] + bv[bj][n]); }
                asm volatile("" ::: "memory"); }
    }
};
struct EpiFF1 {
    static constexpr bool PERM = true, AFTER_DRAIN = false;
    bf16_t* O; const float* bias;
    __device__ __forceinline__ void operator()(const f32x4 (&acc)[2][2][4][2], const pg8::Unit& u, int wr, int wc, int fr, int fq) const {
        const int row0 = u.pm * 256 + wr * 64 + fr, col0 = u.pn * 256 + wc * 32 + 8 * fq;
        f32x4 bv[2][2];
#pragma unroll
        for (int bj = 0; bj < 2; ++bj)
#pragma unroll
            for (int n = 0; n < 2; ++n) bv[bj][n] = *(const f32x4*)(bias + col0 + bj * 128 + 4 * n);
#pragma unroll
        for (int ai = 0; ai < 2; ++ai)
#pragma unroll
            for (int m = 0; m < 4; ++m) { bf16_t* rowp = O + (size_t)(row0 + ai * 128 + m * 16) * DFF + col0;
#pragma unroll
                for (int bj = 0; bj < 2; ++bj) { f32x4 v0 = acc[ai][bj][m][0] + bv[bj][0], v1 = acc[ai][bj][m][1] + bv[bj][1];
#pragma unroll
                    for (int j = 0; j < 4; ++j) { v0[j] = fmaxf(v0[j], 0.f); v0[j] *= v0[j]; v1[j] = fmaxf(v1[j], 0.f); v1[j] *= v1[j]; }
                    u32x4 w; w.x = pk2(v0[0], v0[1]); w.y = pk2(v0[2], v0[3]); w.z = pk2(v1[0], v1[1]); w.w = pk2(v1[2], v1[3]);
                    *(u32x4*)(rowp + bj * 128) = w; } }
    }
};

struct Args { const float* in[23]; float* out; unsigned char* ws; int ph_lo, ph_hi; };
enum { I_XP = 0, I_XS, I_CP, I_CS, I_WADA, I_BADA, I_WIN, I_RPB, I_SLNG, I_SLNB, I_WSP, I_BSP, I_WAUP, I_WSUP, I_WOUT, I_LN1G, I_LN1B, I_WFF1, I_BFF1, I_WFF2, I_BFF2, I_LN2G, I_LN2B };

__device__ __forceinline__ float wave_sum(float v) {
#pragma unroll
    for (int o = 1; o < 64; o <<= 1) v += __shfl_xor(v, o);
    return v;
}
__device__ __forceinline__ void transpose_item(const float* W, int K, int N, bf16_t* WT, int row_off, LAS float* scr, int kb, int nb, int lane) {
    const int k0 = 64 * kb, n0 = 32 * nb;
#pragma unroll 8
    for (int i = 0; i < 32; ++i) { const int kk = 2 * i + (lane >> 5); scr[kk * 33 + (lane & 31)] = W[(size_t)(k0 + kk) * N + n0 + (lane & 31)]; }
    asm volatile("s_waitcnt lgkmcnt(0)" ::: "memory");
    const int c = lane & 7;
#pragma unroll
    for (int j = 0; j < 4; ++j) { const int n = (lane >> 3) + 8 * j; const LAS float* s = scr + (8 * c) * 33 + n;
        u32x4 o; o.x = pk2(s[0 * 33], s[1 * 33]); o.y = pk2(s[2 * 33], s[3 * 33]); o.z = pk2(s[4 * 33], s[5 * 33]); o.w = pk2(s[6 * 33], s[7 * 33]);
        *(u32x4*)(WT + (size_t)(row_off + n0 + n) * K + k0 + 8 * c) = o; }
    asm volatile("s_waitcnt lgkmcnt(0)" ::: "memory");
}

__device__ __forceinline__ void p0_prep(const Args& a, LAS unsigned char* lds, int tid, int wave, int lane) {
    unsigned char* ws = a.ws;
    float* ADA = (float*)(ws + WS_ADA);
    if (blockIdx.x < 96) {
        LAS float* sc = (LAS float*)lds; LAS float* red = (LAS float*)(lds + 40960);
        for (int i = tid; i < 10240; i += 512) { const int b = i >> 10, k = i & 1023; const float c = b < 2 ? a.in[I_CP][b * 1024 + k] : a.in[I_CS][(b - 2) * 1024 + k]; sc[i] = c * __builtin_amdgcn_rcpf(1.0f + __expf(-c)); }
        __syncthreads();
        const int col = blockIdx.x * 64 + lane; const float* wp = a.in[I_WADA] + col;
        float acc[10];
#pragma unroll
        for (int b = 0; b < 10; ++b) acc[b] = 0.f;
#pragma unroll 4
        for (int k = wave * 128; k < wave * 128 + 128; ++k) { const float w = wp[(size_t)k * 6144];
#pragma unroll
            for (int b = 0; b < 10; ++b) acc[b] += sc[b * 1024 + k] * w; }
#pragma unroll
        for (int b = 0; b < 10; ++b) red[(wave * 10 + b) * 64 + lane] = acc[b];
        __syncthreads();
        for (int i = tid; i < 640; i += 512) { const int b = i >> 6, l = i & 63; float s = 0.f;
#pragma unroll
            for (int w = 0; w < 8; ++w) s += red[(w * 10 + b) * 64 + l];
            ADA[b * 6144 + blockIdx.x * 64 + l] = s + a.in[I_BADA][blockIdx.x * 64 + l]; }
        __syncthreads();
    }
    { bf16_t* WSB = (bf16_t*)(ws + WS_WSB); const float* w_s = a.in[I_WSP];
      for (int i = blockIdx.x * 512 + tid; i < 131072 / 2; i += gridDim.x * 512) { const f32x2v v = *(const f32x2v*)(w_s + 2 * i); *(unsigned*)(WSB + 2 * i) = pk2(v.x, v.y); } }
    LAS float* scr = (LAS float*)(lds + wave * 16384);
    const int gw = blockIdx.x * 8 + wave, NGW = gridDim.x * 8;
    constexpr int I_IN = 16 * 144, I_A = 8 * 32, I_S = 8 * 32, I_O = 16 * 32, I_1 = 16 * 128, I_2 = 64 * 32, NIT = I_IN + I_A + I_S + I_O + I_1 + I_2;
    for (int it = gw; it < NIT; it += NGW) {
        int r = it;
        if (r < I_IN) { const int kb = r / 144, nb = r % 144, n0 = nb * 32; const int ro = n0 < 1024 ? 0 : (n0 < 1536 ? 3072 : -512);
            transpose_item(a.in[I_WIN], 1024, 4608, (bf16_t*)(ws + WS_WIN), ro, scr, kb, nb, lane); continue; } r -= I_IN;
        if (r < I_A) { transpose_item(a.in[I_WAUP], 512, 1024, (bf16_t*)(ws + WS_WA), 0, scr, r / 32, r % 32, lane); continue; } r -= I_A;
        if (r < I_S) { transpose_item(a.in[I_WSUP], 512, 1024, (bf16_t*)(ws + WS_WS), 0, scr, r / 32, r % 32, lane); continue; } r -= I_S;
        if (r < I_O) { transpose_item(a.in[I_WOUT], 1024, 1024, (bf16_t*)(ws + WS_WO), 0, scr, r / 32, r % 32, lane); continue; } r -= I_O;
        if (r < I_1) { transpose_item(a.in[I_WFF1], 1024, 4096, (bf16_t*)(ws + WS_W1), 0, scr, r / 128, r % 128, lane); continue; } r -= I_1;
        transpose_item(a.in[I_WFF2], 4096, 1024, (bf16_t*)(ws + WS_W2), 0, scr, r / 32, r % 32, lane);
    }
}

__device__ __forceinline__ void modulate_rows(const float* X, bf16_t* H, const float* ada_shift, int bb0, int tsh, int gw, int ngw, int lane) {
    for (int row = gw; row < NTOK; row += ngw) {
        const float* sh = ada_shift + (size_t)(bb0 + (row >> tsh)) * 6144; const float* scl = sh + 1024;
        const f32x4* xr = (const f32x4*)(X + (size_t)row * D) + lane; u32x2* o = (u32x2*)(H + (size_t)row * D) + lane;
#pragma unroll
        for (int j = 0; j < 4; ++j) { const f32x4 v = xr[64 * j], s = ((const f32x4*)scl)[lane + 64 * j], t = ((const f32x4*)sh)[lane + 64 * j];
            const f32x4 h = v * (s + 1.0f) + t; u32x2 w; w.x = pk2(h[0], h[1]); w.y = pk2(h[2], h[3]); o[64 * j] = w; }
    }
}
__device__ __forceinline__ void ln_rows(float* Y, bf16_t* H2, const float* g, const float* b, const float* ada_shift, int bb0, int tsh, int gw, int ngw, int lane) {
    for (int row = gw; row < NTOK; row += ngw) {
        f32x4* yr = (f32x4*)(Y + (size_t)row * D) + lane;
        f32x4 v[4]; float s = 0.f;
#pragma unroll
        for (int j = 0; j < 4; ++j) { v[j] = yr[64 * j]; s += (v[j][0] + v[j][1]) + (v[j][2] + v[j][3]); }
        const float mean = wave_sum(s) * (1.f / D); float s2 = 0.f;
#pragma unroll
        for (int j = 0; j < 4; ++j) { v[j] = v[j] - mean; s2 += (v[j][0] * v[j][0] + v[j][1] * v[j][1]) + (v[j][2] * v[j][2] + v[j][3] * v[j][3]); }
        const float rstd = 1.0f / sqrtf(wave_sum(s2) * (1.f / D) + LN_EPS);
#pragma unroll
        for (int j = 0; j < 4; ++j) { v[j] = v[j] * rstd * ((const f32x4*)g)[lane + 64 * j] + ((const f32x4*)b)[lane + 64 * j]; yr[64 * j] = v[j]; }
        if (H2) { const float* sh = ada_shift + (size_t)(bb0 + (row >> tsh)) * 6144; const float* scl = sh + 1024; u32x2* o = (u32x2*)(H2 + (size_t)row * D) + lane;
#pragma unroll
            for (int j = 0; j < 4; ++j) { const f32x4 h = v[j] * (((const f32x4*)scl)[lane + 64 * j] + 1.0f) + ((const f32x4*)sh)[lane + 64 * j];
                u32x2 w; w.x = pk2(h[0], h[1]); w.y = pk2(h[2], h[3]); o[64 * j] = w; } }
    }
}

__device__ __forceinline__ void sgu_chunk(const bf16_t* UVS, const bf16_t* WSB, const float* lng, const float* lnb, const float* bsp, bf16_t* SGU, LAS unsigned char* lds, int chunk, int tid, int wave, int lane) {
    const int tok0 = chunk * 128;
    LAS f32x2v* stat = (LAS f32x2v*)(lds + LDS_STAT);
    { const int t = tid >> 2, part = tid & 3; const bf16_t* p = UVS + (size_t)(tok0 + t) * 1024 + 512 + part * 128; float s = 0.f, ss = 0.f;
#pragma unroll
      for (int i = 0; i < 16; ++i) { const u32x4 w = *(const u32x4*)(p + i * 8);
          const float e0 = bflo(w.x), e1 = bfhi(w.x), e2 = bflo(w.y), e3 = bfhi(w.y), e4 = bflo(w.z), e5 = bfhi(w.z), e6 = bflo(w.w), e7 = bfhi(w.w);
          s += ((e0 + e1) + (e2 + e3)) + ((e4 + e5) + (e6 + e7)); ss += ((e0 * e0 + e1 * e1) + (e2 * e2 + e3 * e3)) + ((e4 * e4 + e5 * e5) + (e6 * e6 + e7 * e7)); }
      s += __shfl_xor(s, 1); s += __shfl_xor(s, 2); ss += __shfl_xor(ss, 1); ss += __shfl_xor(ss, 2);
      const float mean = s * (1.f / 512.f), var = fmaxf(ss * (1.f / 512.f) - mean * mean, 0.f);
      if (part == 0) stat[t] = (f32x2v){mean, 1.0f / sqrtf(var + LN_EPS)}; }
    __syncthreads();
    const int g = wave, l15 = lane & 15, s4 = lane >> 4;
    LAS unsigned char* vt = lds + g * 16384;
#pragma unroll
    for (int hh = 0; hh < 2; ++hh) { const int t = lane + 64 * hh; const f32x2v st = stat[t]; const bf16_t* p = UVS + (size_t)(tok0 + t) * 1024 + 512 + g * 64;
#pragma unroll
        for (int c8 = 0; c8 < 8; ++c8) { const u32x4 w = *(const u32x4*)(p + c8 * 8); const unsigned ww[4] = {w.x, w.y, w.z, w.w};
#pragma unroll
            for (int e = 0; e < 8; ++e) { const int c = c8 * 8 + e; const float x = (e & 1) ? bfhi(ww[e >> 1]) : bflo(ww[e >> 1]);
                const float y = (x - st.x) * st.y * lng[g * 64 + c] + lnb[g * 64 + c];
                const int addr = c * 256 + ((((t >> 3) ^ (c & 15)) << 4) | ((t & 7) * 2));
                *(LAS bf16_t*)(vt + addr) = (bf16_t)(pk2(y, 0.f) & 0xffffu); } } }
    asm volatile("s_waitcnt lgkmcnt(0)" ::: "memory");
    bf16x8 af[4][4];
#pragma unroll
    for (int ct = 0; ct < 4; ++ct)
#pragma unroll
        for (int kk = 0; kk < 4; ++kk) af[ct][kk] = *(const LAS bf16x8*)(vt + (ct * 16 + l15) * 256 + (((kk * 4 + s4) ^ l15) << 4));
#pragma unroll 1
    for (int pt = 0; pt < 8; ++pt) {
        const bf16_t* wp = WSB + (size_t)(g * 128 + pt * 16 + l15) * 128 + s4 * 8;
        bf16x8 bf[4];
#pragma unroll
        for (int kk = 0; kk < 4; ++kk) bf[kk] = *(const bf16x8*)(wp + kk * 32);
        f32x4 acc[4];
#pragma unroll
        for (int ct = 0; ct < 4; ++ct) { acc[ct] = (f32x4){0.f, 0.f, 0.f, 0.f};
#pragma unroll
            for (int kk = 0; kk < 4; ++kk) acc[ct] = __builtin_amdgcn_mfma_f32_16x16x32_bf16(af[ct][kk], bf[kk], acc[ct], 0, 0, 0); }
        const int p = pt * 16 + l15; const float bias = bsp[g * 128 + p];
#pragma unroll
        for (int ct = 0; ct < 4; ++ct) { const int c = g * 64 + ct * 16 + s4 * 4;
            const u32x2 uu = *(const u32x2*)(UVS + (size_t)(tok0 + p) * 1024 + c);
            u32x2 w; w.x = pk2(bflo(uu.x) * (acc[ct][0] + bias), bfhi(uu.x) * (acc[ct][1] + bias)); w.y = pk2(bflo(uu.y) * (acc[ct][2] + bias), bfhi(uu.y) * (acc[ct][3] + bias));
            *(u32x2*)(SGU + (size_t)(tok0 + p) * 512 + c) = w; }
    }
    __syncthreads();
}

__device__ __forceinline__ void attn_item(const bf16_t* QK, const bf16_t* VT, bf16_t* ATT, const LAS float* rpb, int item, int rows_pb, int lane) {
    const int cb = item & 3, h = (item >> 2) & 7, R = item >> 5;
    const int b = R / rows_pb, r = R - b * rows_pb;
    int rs = r - 4; rs = rs < 0 ? 0 : (rs > rows_pb - 8 ? rows_pb - 8 : rs);
    const int kc0 = cb == 0 ? 0 : (cb == 1 ? 8 : (cb == 2 ? 24 : 32));
    const int l15 = lane & 15, s4 = lane >> 4;
    const int tq = R * 64 + cb * 16 + l15;
    const bf16_t* qp = QK + (size_t)tq * 1024 + h * 64 + s4 * 8;
    const bf16x8 qf0 = *(const bf16x8*)qp, qf1 = *(const bf16x8*)(qp + 32);
    const int krow0 = (b * rows_pb + rs) * 64;
    const bf16_t* kbase = QK + (size_t)(krow0 + kc0 + (l15 >> 2) * 8 + (l15 & 3)) * 1024 + 512 + h * 64 + s4 * 8;
    f32x4 sc[16];
#pragma unroll
    for (int i = 0; i < 8; ++i)
#pragma unroll
        for (int hf = 0; hf < 2; ++hf) { const bf16_t* kp = kbase + (size_t)(i * 64 + hf * 4) * 1024;
            const bf16x8 k0 = *(const bf16x8*)kp, k1 = *(const bf16x8*)(kp + 32);
            f32x4 z = (f32x4){0.f, 0.f, 0.f, 0.f};
            z = __builtin_amdgcn_mfma_f32_16x16x32_bf16(k0, qf0, z, 0, 0, 0); z = __builtin_amdgcn_mfma_f32_16x16x32_bf16(k1, qf1, z, 0, 0, 0); sc[i * 2 + hf] = z; }
    const int qc = cb * 16 + l15; int cs = qc - 8; cs = cs < 0 ? 0 : (cs > 48 ? 48 : cs);
    const LAS float* rp = rpb + h * 465 + (rs - r + 7) * 31;
    float mx = -3.0e38f;
#pragma unroll
    for (int i = 0; i < 8; ++i)
#pragma unroll
        for (int hf = 0; hf < 2; ++hf)
#pragma unroll
            for (int j = 0; j < 4; ++j) { const int kc = kc0 + s4 * 8 + hf * 4 + j; const bool valid = (kc >= cs) && (kc < cs + 16);
                int dc = kc - qc + 15; dc = dc < 0 ? 0 : (dc > 30 ? 30 : dc);
                const float v = valid ? sc[i * 2 + hf][j] + rp[i * 31 + dc] : -3.0e38f; sc[i * 2 + hf][j] = v; mx = fmaxf(mx, v); }
    mx = fmaxf(mx, __shfl_xor(mx, 16)); mx = fmaxf(mx, __shfl_xor(mx, 32));
    float sum = 0.f;
#pragma unroll
    for (int t = 0; t < 16; ++t)
#pragma unroll
        for (int j = 0; j < 4; ++j) { const float p = __builtin_amdgcn_exp2f((sc[t][j] - mx) * 1.4426950408889634f); sc[t][j] = p; sum += p; }
    sum += __shfl_xor(sum, 16); sum += __shfl_xor(sum, 32);
    const float inv = 1.0f / sum;
    f32x4 o[4];
#pragma unroll
    for (int dt = 0; dt < 4; ++dt) o[dt] = (f32x4){0.f, 0.f, 0.f, 0.f};
    const bf16_t* vbase = VT + (size_t)(h * 64 + l15) * NTOK + krow0 + kc0 + s4 * 8;
#pragma unroll
    for (int i = 0; i < 8; ++i) {
        u32x4 pw; pw.x = pk2(sc[2 * i][0], sc[2 * i][1]); pw.y = pk2(sc[2 * i][2], sc[2 * i][3]); pw.z = pk2(sc[2 * i + 1][0], sc[2 * i + 1][1]); pw.w = pk2(sc[2 * i + 1][2], sc[2 * i + 1][3]);
        const bf16x8 pf = __builtin_bit_cast(bf16x8, pw);
#pragma unroll
        for (int dt = 0; dt < 4; ++dt) { const bf16x8 vf = *(const bf16x8*)(vbase + (size_t)(dt * 16) * NTOK + i * 64);
            o[dt] = __builtin_amdgcn_mfma_f32_16x16x32_bf16(vf, pf, o[dt], 0, 0, 0); }
    }
    bf16_t* op = ATT + (size_t)tq * 512 + h * 64 + s4 * 4;
#pragma unroll
    for (int dt = 0; dt < 4; ++dt) { u32x2 w; w.x = pk2(o[dt][0] * inv, o[dt][1] * inv); w.y = pk2(o[dt][2] * inv, o[dt][3] * inv); *(u32x2*)(op + dt * 16) = w; }
}

constexpr size_t WS_BAR = WS_END;
constexpr size_t WS_END2 = WS_BAR + 16384;
constexpr int LDS_XB = LDS_BYTES - 16;
#ifdef ONLY_SUB
#define EN(k) ((k) == ONLY_SUB)
#else
#define EN(k) true
#endif
__global__ void __launch_bounds__(512, 2) mk_fwd(Args a) {
    extern __shared__ __attribute__((aligned(16))) unsigned char lds_raw[];
    LAS unsigned char* lds = (LAS unsigned char*)lds_raw;
    cg::grid_group grid = cg::this_grid();
    if (threadIdx.x < 4) ((LAS unsigned*)(lds + LDS_XB))[threadIdx.x] = 0u;
    __syncthreads();
    XcdBarrier xbar = xcd_barrier_post((unsigned*)(a.ws + WS_BAR), (volatile LAS unsigned*)(lds + LDS_XB));
#pragma unroll 1
    for (int ph = a.ph_lo; ph < a.ph_hi; ++ph) {
    int tid_l = threadIdx.x; asm volatile("" : "+v"(tid_l)); const int tid = tid_l, lane = tid & 63, wave = __builtin_amdgcn_readfirstlane(tid >> 6);
    const int G = gridDim.x, gw = blockIdx.x * 8 + wave, ngw = G * 8;
    unsigned char* ws = a.ws; asm volatile("" : "+s"(ws));
    const float* ADA = (const float*)(ws + WS_ADA);
    bf16_t* H = (bf16_t*)(ws + WS_H); bf16_t* Z = (bf16_t*)(ws + WS_Z); bf16_t* VT = (bf16_t*)(ws + WS_VT); bf16_t* ATT = (bf16_t*)(ws + WS_ATT); bf16_t* SGU = (bf16_t*)(ws + WS_SGU);
    bf16_t* QK = Z; bf16_t* UVS = Z + (size_t)NTOK * 1024; bf16_t* GA = Z + (size_t)2 * NTOK * 1024; bf16_t* GB = Z + (size_t)3 * NTOK * 1024;
    const bf16_t* WinT = (const bf16_t*)(ws + WS_WIN); const bf16_t* WaT = (const bf16_t*)(ws + WS_WA); const bf16_t* WsT = (const bf16_t*)(ws + WS_WS);
    const bf16_t* WoT = (const bf16_t*)(ws + WS_WO); const bf16_t* W1T = (const bf16_t*)(ws + WS_W1); const bf16_t* W2T = (const bf16_t*)(ws + WS_W2);
        if (ph == 0 && EN(-1)) { p0_prep(a, lds, tid, wave, lane); }
        else {
            const int ck = (ph - 1) / 9, sub = (ph - 1) % 9;
            const float* X = ck == 0 ? a.in[I_XP] : a.in[I_XS]; float* OUT = a.out + (size_t)ck * NTOK * D;
            const int bb0 = ck == 0 ? 0 : 2, tsh = ck == 0 ? 14 : 12, bsh = tsh - 8, rows_pb = ck == 0 ? 256 : 64;
            if (sub == 0 && EN(0)) { modulate_rows(X, H, ADA, bb0, tsh, gw, ngw, lane); }
            else if (sub == 1 && EN(1)) {
                { pg8::Gemm g{H, WinT, NTOK, 4096, 1024}; pg8::StaticOrder S; S.init(NTOK, 4096, G, (int)blockIdx.x); EpiZ E{Z};
                  pg8::gemm_phase<EpiZ, pg8::StaticOrder, false>(lds, g, S, E, nullptr); }
                { pg8::Gemm g{WinT + (size_t)4096 * 1024, H, 512, NTOK, 1024}; pg8::StaticOrder S; S.init(512, NTOK, G, (int)blockIdx.x); EpiPlain E{VT, NTOK};
                  pg8::gemm_phase<EpiPlain, pg8::StaticOrder, false>(lds, g, S, E, nullptr); }
            }
            else if (sub == 2 && EN(2)) {
                LAS float* rpb = (LAS float*)(lds + LDS_RPB);
                for (int i = tid; i < 3720; i += 512) rpb[i] = a.in[I_RPB][i];
                for (int ch = blockIdx.x; ch < NTOK / 128; ch += G)
                    sgu_chunk(UVS, (const bf16_t*)(ws + WS_WSB), a.in[I_SLNG], a.in[I_SLNB], a.in[I_BSP], SGU, lds, ch, tid, wave, lane);
                __syncthreads();
                for (int it = gw; it < (NTOK / 16) * 8; it += ngw) attn_item(QK, VT, ATT, rpb, it, rows_pb, lane);
            }
            else if (sub == 3 && EN(3)) {
                { pg8::Gemm g{ATT, WaT, NTOK, 1024, 512}; pg8::StaticOrder S; S.init(NTOK, 1024, G, (int)blockIdx.x); EpiGate<0> E{GA, H};
                  pg8::gemm_phase<EpiGate<0>, pg8::StaticOrder, false>(lds, g, S, E, nullptr); }
                { pg8::Gemm g{SGU, WsT, NTOK, 1024, 512}; pg8::StaticOrder S; S.init(NTOK, 1024, G, (int)blockIdx.x); EpiGate<1> E{GB, H};
                  pg8::gemm_phase<EpiGate<1>, pg8::StaticOrder, false>(lds, g, S, E, nullptr); }
            }
            else if (sub == 4 && EN(4)) { pg8::Gemm g{H, WoT, NTOK, 1024, 1024}; pg8::StaticOrder S; S.init(NTOK, 1024, G, (int)blockIdx.x); EpiRes E{X, OUT, ADA + 2 * 1024, nullptr, bb0, bsh};
                pg8::gemm_phase<EpiRes, pg8::StaticOrder, false>(lds, g, S, E, nullptr); }
            else if (sub == 5 && EN(5)) { ln_rows(OUT, H, a.in[I_LN1G], a.in[I_LN1B], ADA + 3 * 1024, bb0, tsh, gw, ngw, lane); }
            else if (sub == 6 && EN(6)) { pg8::Gemm g{H, W1T, NTOK, 4096, 1024}; pg8::StaticOrder S; S.init(NTOK, 4096, G, (int)blockIdx.x); EpiFF1 E{Z, a.in[I_BFF1]};
                pg8::gemm_phase<EpiFF1, pg8::StaticOrder, false>(lds, g, S, E, nullptr); }
            else if (sub == 7 && EN(7)) { pg8::Gemm g{Z, W2T, NTOK, 1024, 4096}; pg8::StaticOrder S; S.init(NTOK, 1024, G, (int)blockIdx.x); EpiRes E{OUT, OUT, ADA + 5 * 1024, a.in[I_BFF2], bb0, bsh};
                pg8::gemm_phase<EpiRes, pg8::StaticOrder, false>(lds, g, S, E, nullptr); }
            else if (EN(8)) { ln_rows(OUT, nullptr, a.in[I_LN2G], a.in[I_LN2B], ADA, bb0, tsh, gw, ngw, lane); }
        }
        if (ph + 1 < a.ph_hi) { if (ph == 0) { __threadfence(); grid.sync(); } else xcd_barrier(xbar); }
    }
}

extern "C" void kernel_launch(void* const* d_in, const int* in_sizes, int n_in, void* d_out, int out_size, void* d_ws, size_t ws_size, hipStream_t stream) {
    static int grid = 0;
    if (grid == 0) {
        if (n_in != 23 || ws_size < WS_END2) { fprintf(stderr, "kernel_launch: n_in %d ws %zu (need %zu)\n", n_in, ws_size, (size_t)WS_END2); grid = -1; return; }
        int dev = 0, cus = 0, per_cu = 0;
        hipGetDevice(&dev); hipDeviceGetAttribute(&cus, hipDeviceAttributeMultiprocessorCount, dev);
        if (hipFuncSetAttribute((const void*)mk_fwd, hipFuncAttributeMaxDynamicSharedMemorySize, LDS_BYTES) != hipSuccess) { fprintf(stderr, "kernel_launch: hipFuncSetAttribute failed\n"); grid = -1; return; }
        hipOccupancyMaxActiveBlocksPerMultiprocessor(&per_cu, (const void*)mk_fwd, 512, LDS_BYTES);
        (void)hipGetLastError();
        if (per_cu < 1) fprintf(stderr, "kernel_launch: occupancy query says %d blocks per CU\n", per_cu);
        grid = cus > 0 ? cus : 256;
    }
    if (grid < 0) return;
    Args a{};
    for (int i = 0; i < 23; ++i) a.in[i] = (const float*)d_in[i];
    a.out = (float*)d_out; a.ws = (unsigned char*)d_ws;
    if (hipMemsetAsync((char*)d_ws + WS_BAR, 0, 16384, stream) != hipSuccess) { fprintf(stderr, "memset failed\n"); return; }
#if MK_MULTI
    for (int ph = 0; ph < NPH; ++ph) { a.ph_lo = ph; a.ph_hi = ph + 1; hipLaunchKernelGGL(mk_fwd, dim3(grid), dim3(512), LDS_BYTES, stream, a); }
#else
    a.ph_lo = 0; a.ph_hi = NPH;
    void* args[] = {&a};
    hipError_t e = hipLaunchCooperativeKernel((const void*)mk_fwd, dim3(grid), dim3(512), args, LDS_BYTES, stream);
    if (e != hipSuccess) fprintf(stderr, "cooperative launch failed: %s (grid %d)\n", hipGetErrorString(e), grid);
#endif
}
```

```cpp
#include <hip/hip_runtime.h>
#include <hip/hip_cooperative_groups.h>
#include <cstdio>
namespace cg = cooperative_groups;
#ifndef MK_MULTI
#define MK_MULTI 0
#endif
namespace pg8 {
#define PG8_LAS __attribute__((address_space(3)))
typedef unsigned short bf16_t;
typedef short bf16x8 __attribute__((ext_vector_type(8)));
typedef float f32x4 __attribute__((ext_vector_type(4)));
typedef unsigned u32x4 __attribute__((ext_vector_type(4)));
constexpr int BM = 256, BK = 64, HALF = 128, HTB = HALF * BK * 2  , STAGE_BYTES = 8 * HTB, NXCD = 8, WGM = 8;

__host__ __device__ __forceinline__ int lds_byte(int r, int c) { const int st = (r >> 4) * 2 + (c >> 5), rr = r & 15, cc = c & 31, ob = rr * 64 + cc * 2; return st * 1024 + (ob ^ (((ob >> 9) & 1) << 5)); }
__host__ __device__ __forceinline__ void stage_rc(int b, int& R, int& C) { const int st = b / 1024, sb = b % 1024, swz = sb ^ (((sb >> 9) & 1) << 5); R = (st >> 1) * 16 + swz / 64; C = (st & 1) * 32 + (swz % 64) / 2; }
__host__ __device__ __forceinline__ int perm32(int rho) { const int n = rho >> 4, i = rho & 15; return 8 * (i >> 2) + 4 * n + (i & 3); }

struct Unit { int pm, pn; };
struct Gemm { const bf16_t* A; const bf16_t* Bt; int M, N, K; };

struct StaticOrder {
    int nM, nN, nwg, G, c;
    __host__ __device__ void init(int M, int N, int G_, int c_) { nM = M / BM; nN = N / BM; nwg = nM * nN; G = G_; c = c_; }
    __host__ __device__ bool next(int i, Unit& u) const {
        const long L = (long)i * G + c; if (L >= nwg) return false;
        int wgid = (int)L; { const int q = nwg / NXCD, r = nwg % NXCD, xcd = wgid % NXCD, off = wgid / NXCD; wgid = (xcd < r ? xcd * (q + 1) : r * (q + 1) + (xcd - r) * q) + off; }
        const int nig = WGM * nN, gid = wgid / nig, fm = gid * WGM, gsz = (nM - fm) < WGM ? (nM - fm) : WGM;
        u.pm = fm + ((wgid % nig) % gsz); u.pn = (wgid % nig) / gsz; return true;
    }
    __device__ __forceinline__ void a_ready(const Unit&) const {}
    __device__ __forceinline__ void done(const Unit&) const {}
};
__device__ __forceinline__ unsigned cvt_pk_bf16(float lo, float hi) { unsigned r; asm volatile("v_cvt_pk_bf16_f32 %0, %1, %2" : "=v"(r) : "v"(lo), "v"(hi)); return r; }
typedef float f32x2 __attribute__((ext_vector_type(2)));
__device__ __forceinline__ f32x2 gelu_pk(f32x2 v) {
    const f32x2 av = __builtin_elementwise_abs(v), d = av * 0.2316418882f + 1.0f;
    f32x2 t; t.x = __builtin_amdgcn_rcpf(d.x); t.y = __builtin_amdgcn_rcpf(d.y);
    f32x2 q = t * 0.5307027145f + (-0.7265760135f); q = q * t + 0.7107068705f; q = q * t + (-0.142248368f); q = q * t + 0.127414796f; q = q * t;
    const f32x2 s = (v * v) * (-0.72134752044f);
    f32x2 e; e.x = __builtin_amdgcn_exp2f(s.x); e.y = __builtin_amdgcn_exp2f(s.y);
    const f32x2 m = v * (q * e), r = v - m;
    f32x2 o; o.x = v.x < 0.f ? m.x : r.x; o.y = v.y < 0.f ? m.y : r.y; return o;
}
template <class Epi, class Sched, bool STAMP = false>
__device__ __forceinline__ void gemm_phase(PG8_LAS unsigned char* lds, const Gemm g, const Sched& S, const Epi& E, unsigned long long* stamps) {
    int tid_l = threadIdx.x; asm volatile("" : "+v"(tid_l)); const int tid = tid_l, wid = __builtin_amdgcn_readfirstlane(tid >> 6), lane = tid & 63, wr = wid >> 2, wc = wid & 3, fr = lane & 15, fq = lane >> 4;
    const int K = g.K, nt = K / BK;
    int ts_lo = 0, ts_hi = 0, nts = 0; const unsigned long long rt_entry = STAMP ? (unsigned long long)wall_clock64() : 0ull;
#define PG8_STAMP() do { if (STAMP && wid == 0 && nts < 64) { const unsigned long long _c = (unsigned long long)clock64(); \
        ts_lo = (lane == nts) ? (int)(unsigned)_c : ts_lo; ts_hi = (lane == nts) ? (int)(unsigned)(_c >> 32) : ts_hi; ++nts; } } while (0)
    PG8_STAMP();
    unsigned voffA[2], voffB[2];
#pragma unroll
    for (int i = 0; i < 2; ++i) { int R, C; stage_rc(tid * 16 + i * 8192, R, C); const int Rb = Epi::PERM ? ((R & ~31) + perm32(R & 31)) : R;
        voffA[i] = (unsigned)(R * K + C) * 2u; voffB[i] = (unsigned)(Rb * K + C) * 2u; }
    const size_t kstep = (size_t)(BK * 2);
    const size_t hstep = (size_t)HALF * K * 2;
    const size_t tstep = 2 * hstep;
    const unsigned ldsw = (unsigned)wid * 1024u;
    const int aoff = lds_byte(wr * 64 + fr, fq * 8), boff = lds_byte(wc * 32 + fr, fq * 8);
#define PG8_SA(b, h) (((b) * 2 + (h)) * HTB)
#define PG8_SB(b, h) ((4 + (b) * 2 + (h)) * HTB)
#define PG8_STAGE(bufoff, gbase, voff) do { _Pragma("unroll") for (int _i = 0; _i < 2; ++_i) \
        __builtin_amdgcn_global_load_lds((const unsigned*)((const char*)(gbase) + (voff)[_i]), (PG8_LAS unsigned*)(lds + (bufoff) + ldsw + _i * 8192), 16, 0, 0); } while (0)
#define PG8_LDA(dst, b, h) do { _Pragma("unroll") for (int m = 0; m < 4; ++m) _Pragma("unroll") for (int k = 0; k < 2; ++k) dst[m][k] = *(const PG8_LAS bf16x8*)(lds + PG8_SA(b, h) + aoff + m * 2048 + k * 1024); } while (0)
#define PG8_LDB(dst, b, h) do { _Pragma("unroll") for (int n = 0; n < 2; ++n) _Pragma("unroll") for (int k = 0; k < 2; ++k) dst[n][k] = *(const PG8_LAS bf16x8*)(lds + PG8_SB(b, h) + boff + n * 2048 + k * 1024); } while (0)
#define PG8_MMA(ai, bj, At, Bt) do { __builtin_amdgcn_s_setprio(1); _Pragma("unroll") for (int m = 0; m < 4; ++m) _Pragma("unroll") for (int n = 0; n < 2; ++n) _Pragma("unroll") for (int k = 0; k < 2; ++k) \
        acc[ai][bj][m][n] = __builtin_amdgcn_mfma_f32_16x16x32_bf16(Bt[n][k], At[m][k], acc[ai][bj][m][n], 0, 0, 0); __builtin_amdgcn_s_setprio(0); } while (0)
#define PG8_WAIT_V(n) asm volatile("s_waitcnt vmcnt(" #n ")" ::: "memory")
#define PG8_WAIT_L(n) asm volatile("s_waitcnt lgkmcnt(" #n ")" ::: "memory")
#define PG8_BAR __builtin_amdgcn_s_barrier()
#define PG8_SCHED __builtin_amdgcn_sched_barrier(0)
    Unit cur, nxt; int ui = 0;
    if (!S.next(0, cur)) return;
    f32x4 acc[2][2][4][2];
#pragma unroll
    for (int a = 0; a < 2; ++a)
#pragma unroll
        for (int b = 0; b < 2; ++b)
#pragma unroll
            for (int m = 0; m < 4; ++m)
#pragma unroll
                for (int n = 0; n < 2; ++n) acc[a][b][m][n] = (f32x4){0.f, 0.f, 0.f, 0.f};
    bf16x8 At[4][2], B0[2][2], B1[2][2];
    const char* cA = (const char*)g.A + (size_t)cur.pm * tstep; const char* cB = (const char*)g.Bt + (size_t)cur.pn * tstep;
    S.a_ready(cur);
    PG8_STAGE(PG8_SB(0, 0), cB, voffB); PG8_STAGE(PG8_SA(0, 0), cA, voffA); PG8_STAGE(PG8_SB(0, 1), cB + hstep, voffB); PG8_STAGE(PG8_SA(0, 1), cA + hstep, voffA);
    if (wr == 1) PG8_BAR;
    PG8_WAIT_V(4); PG8_BAR;
    PG8_STAGE(PG8_SB(1, 0), cB + kstep, voffB); PG8_STAGE(PG8_SA(1, 0), cA + kstep, voffA); PG8_STAGE(PG8_SB(1, 1), cB + hstep + kstep, voffB);
    PG8_WAIT_V(6); PG8_BAR;
    PG8_STAMP();
    for (;;) {
        const bool has_next = S.next(ui + 1, nxt);
        const char* nA = has_next ? (const char*)g.A + (size_t)nxt.pm * tstep : cA; const char* nB = has_next ? (const char*)g.Bt + (size_t)nxt.pn * tstep : cB;
        for (int t = 0; t < nt; t += 2) {
            const bool last = (t == nt - 2);
            const char* a1 = cA + (size_t)(t + 1) * kstep;
            const char* a2 = last ? nA : cA + (size_t)(t + 2) * kstep; const char* b2 = last ? nB : cB + (size_t)(t + 2) * kstep;
            const char* a3 = a2 + kstep; const char* b3 = b2 + kstep;
            if (last && has_next) S.a_ready(nxt);
            PG8_LDB(B0, 0, 0); PG8_SCHED; PG8_LDA(At, 0, 0); PG8_STAGE(PG8_SA(1, 1), a1 + hstep, voffA);
            PG8_WAIT_L(8); PG8_BAR; PG8_WAIT_L(0); PG8_MMA(0, 0, At, B0); PG8_BAR; PG8_SCHED;
            PG8_LDB(B1, 0, 1); PG8_STAGE(PG8_SB(0, 0), b2, voffB);
            PG8_BAR; PG8_WAIT_L(0); PG8_MMA(0, 1, At, B1); PG8_BAR;
            PG8_LDA(At, 0, 1); PG8_STAGE(PG8_SA(0, 0), a2, voffA);
            PG8_BAR; PG8_WAIT_L(0); PG8_MMA(1, 0, At, B0); PG8_BAR; PG8_SCHED;
            PG8_STAGE(PG8_SB(0, 1), b2 + hstep, voffB);
            PG8_WAIT_V(6); PG8_BAR; PG8_MMA(1, 1, At, B1); PG8_BAR;
            PG8_LDB(B0, 1, 0); PG8_SCHED; PG8_LDA(At, 1, 0); PG8_STAGE(PG8_SA(0, 1), a2 + hstep, voffA);
            PG8_WAIT_L(8); PG8_BAR; PG8_WAIT_L(0); PG8_MMA(0, 0, At, B0); PG8_BAR; PG8_SCHED;
            PG8_LDB(B1, 1, 1); PG8_STAGE(PG8_SB(1, 0), b3, voffB);
            PG8_BAR; PG8_WAIT_L(0); PG8_MMA(0, 1, At, B1); PG8_BAR;
            PG8_LDA(At, 1, 1); PG8_STAGE(PG8_SA(1, 0), a3, voffA);
            PG8_BAR; PG8_WAIT_L(0); PG8_MMA(1, 0, At, B0); PG8_BAR; PG8_SCHED;
            PG8_STAGE(PG8_SB(1, 1), b3 + hstep, voffB);
            PG8_WAIT_V(6); PG8_BAR; PG8_MMA(1, 1, At, B1); PG8_BAR;
        }
        PG8_STAMP();
        if constexpr (!Epi::AFTER_DRAIN) { E(acc, cur, wr, wc, fr, fq); S.done(cur); }
        PG8_STAMP();
        if (!has_next) break;
#pragma unroll
        for (int a = 0; a < 2; ++a)
#pragma unroll
            for (int b = 0; b < 2; ++b)
#pragma unroll
                for (int m = 0; m < 4; ++m)
#pragma unroll
                    for (int n = 0; n < 2; ++n) acc[a][b][m][n] = (f32x4){0.f, 0.f, 0.f, 0.f};
        cur = nxt; cA = nA; cB = nB; ++ui;
    }
    PG8_WAIT_V(0);
    if (wr == 0) PG8_BAR;
    PG8_BAR;
    if constexpr (Epi::AFTER_DRAIN) { E.fused(acc, cur, wr, wc, fr, fq, lds, wid, lane); S.done(cur); }
    PG8_STAMP();
    if (STAMP && wid == 0) { stamps[lane] = lane < nts ? (((unsigned long long)(unsigned)ts_hi << 32) | (unsigned)ts_lo) : 0ull;
        if (lane == 62) stamps[62] = rt_entry; if (lane == 63) stamps[63] = (unsigned long long)wall_clock64(); }
#undef PG8_STAMP
#undef PG8_SA
#undef PG8_SB
#undef PG8_STAGE
#undef PG8_LDA
#undef PG8_LDB
#undef PG8_MMA
#undef PG8_WAIT_V
#undef PG8_WAIT_L
#undef PG8_BAR
#undef PG8_SCHED
}
}
#define LAS __attribute__((address_space(3)))
#define XB_TMO      128
#define XB_XCNT(j)  (256  + 64 * (j))
#define XB_XSUB(j)  (1280 + 64 * (j))
#define XB_XGEN(j)  (2304 + 64 * (j))
#define XB_TOP      3328
#define XB_TOPGEN   3392
#define XCD_BAR_WORDS 3456
#define XB_SPIN_CAP (1u << 18)

__device__ __forceinline__ unsigned xb_ld(unsigned* p)              { return __hip_atomic_load(p, __ATOMIC_RELAXED, __HIP_MEMORY_SCOPE_AGENT); }
__device__ __forceinline__ unsigned xb_add(unsigned* p, unsigned v) { return __hip_atomic_fetch_add(p, v, __ATOMIC_RELAXED, __HIP_MEMORY_SCOPE_AGENT); }
__device__ __forceinline__ unsigned xb_xcc_id() { return (unsigned)__builtin_amdgcn_s_getreg((3 << 11) | 20) & 0xFu; }
#define XB_SPIN(cond, bar) do { unsigned _sp = 0; while (cond) { __builtin_amdgcn_s_sleep(1); \
    if ((++_sp & 255u) == 0u) { if (xb_ld(&(bar)[XB_TMO])) break; if (_sp > XB_SPIN_CAP) { atomicAdd(&(bar)[XB_TMO], 1u); break; } } } } while (0)

struct XcdBarrier {
    unsigned* bar; unsigned x;
    volatile LAS unsigned* st;
};

__device__ __forceinline__ XcdBarrier xcd_barrier_post(unsigned* bar, volatile LAS unsigned* st) {
    XcdBarrier b; b.bar = bar; b.x = xb_xcc_id(); b.st = st;
    if (threadIdx.x == 0) (void)xb_add(&bar[XB_XCNT(b.x)], 1u);
    return b;
}
__device__ __forceinline__ void xcd_barrier_complete(unsigned* bar, unsigned x, unsigned& nloc, unsigned& nx) {
    const unsigned G = gridDim.x * gridDim.y * gridDim.z;
    unsigned sum, cnt, mine, sp = 0u;
    for (;;) {
        sum = 0u; cnt = 0u; mine = 0u;
#pragma unroll
        for (unsigned j = 0; j < 16; ++j) { const unsigned c = xb_ld(&bar[XB_XCNT(j)]); sum += c; cnt += (c > 0u) ? 1u : 0u; mine = (j == x) ? c : mine; }
        if (sum == G) break;
        __builtin_amdgcn_s_sleep(1);
        if ((++sp & 255u) == 0u) { if (xb_ld(&bar[XB_TMO])) break; if (sp > XB_SPIN_CAP) { atomicAdd(&bar[XB_TMO], 1u); break; } }
    }
    nloc = mine > 0u ? mine : 1u; nx = cnt > 0u ? cnt : 1u;
}

__device__ __forceinline__ void xcd_barrier(const XcdBarrier& b) {
    asm volatile("s_waitcnt vmcnt(0)" ::: "memory");
    __syncthreads();
    if (threadIdx.x == 0) {
        unsigned* bar = b.bar;
        __builtin_amdgcn_s_waitcnt(0);
        unsigned nloc = b.st[0], nx = b.st[1];
        if (nloc == 0u) { xcd_barrier_complete(bar, b.x, nloc, nx); b.st[0] = nloc; b.st[1] = nx; }
        const unsigned old = xb_add(&bar[XB_XSUB(b.x)], 1u);
        const unsigned gen = old / nloc;
        if (old + 1u == (gen + 1u) * nloc) {
            __builtin_amdgcn_fence(__ATOMIC_RELEASE, "agent");
            asm volatile("s_waitcnt vmcnt(0)" ::: "memory");
            const unsigned og = xb_add(&bar[XB_TOP], 1u);
            const unsigned tg = og / nx;
            if (og + 1u == (tg + 1u) * nx) xb_add(&bar[XB_TOPGEN], 1u);
            else XB_SPIN(xb_ld(&bar[XB_TOPGEN]) == tg, bar);
            __builtin_amdgcn_fence(__ATOMIC_ACQUIRE, "agent");
            xb_add(&bar[XB_XGEN(b.x)], 1u);
            asm volatile("s_waitcnt vmcnt(0)" ::: "memory");
        } else {
            XB_SPIN(xb_ld(&bar[XB_XGEN(b.x)]) == gen, bar);
            __builtin_amdgcn_fence(__ATOMIC_ACQUIRE, "agent");
            asm volatile("s_waitcnt vmcnt(0)" ::: "memory");
        }
    }
    __syncthreads();
}
typedef unsigned short bf16_t;
using pg8::bf16x8; using pg8::f32x4; using pg8::u32x4;
typedef unsigned u32x2 __attribute__((ext_vector_type(2)));
typedef float f32x2v __attribute__((ext_vector_type(2)));

constexpr int D = 1024, DFF = 4096, NTOK = 32768, NPH = 19;
constexpr float ALPHA = 1.189207115002721f, LN_EPS = 1e-5f;
constexpr int LDS_BYTES = 155648, LDS_STAT = 131072, LDS_VRING = 73728, LDS_RPB = 147456;
constexpr size_t MiB = 1048576;
constexpr size_t WS_ADA = 0, WS_WSB = 262144, WS_WIN = 524288, WS_WA = WS_WIN + 9 * MiB, WS_WS = WS_WA + MiB, WS_WO = WS_WS + MiB, WS_W1 = WS_WO + 2 * MiB,
                 WS_W2 = WS_W1 + 8 * MiB, WS_H = 30 * MiB, WS_Z = WS_H + 64 * MiB, WS_VT = WS_Z + 256 * MiB, WS_ATT = WS_VT + 32 * MiB, WS_SGU = WS_ATT + 32 * MiB,
                 WS_END = WS_SGU + 32 * MiB;

__device__ __forceinline__ unsigned pk2(float lo, float hi) { return pg8::cvt_pk_bf16(lo, hi); }
__device__ __forceinline__ float bflo(unsigned w) { return __uint_as_float(w << 16); }
__device__ __forceinline__ float bfhi(unsigned w) { return __uint_as_float(w & 0xffff0000u); }
__device__ __forceinline__ float sigmoidf_(float x) { return __builtin_amdgcn_rcpf(1.0f + __expf(-x)); }
__device__ __forceinline__ float gelu_tanh(float x) { const float t = x * (1.5957691216057308f + 0.07135481627260025f * x * x); return x * __builtin_amdgcn_rcpf(1.0f + __expf(-t)); }

struct EpiZ {
    static constexpr bool PERM = true, AFTER_DRAIN = false;
    bf16_t* O;
    __device__ __forceinline__ void operator()(const f32x4 (&acc)[2][2][4][2], const pg8::Unit& u, int wr, int wc, int fr, int fq) const {
        const int row0 = u.pm * 256 + wr * 64 + fr;
        bf16_t* base = O + (size_t)(u.pn >> 2) * ((size_t)NTOK * 1024) + ((u.pn & 3) * 256 + wc * 32 + 8 * fq);
        const int mode = u.pn < 2 ? 0 : (u.pn < 4 ? 1 : (u.pn < 8 ? 2 : 3));
#pragma unroll
        for (int ai = 0; ai < 2; ++ai)
#pragma unroll
            for (int m = 0; m < 4; ++m) { bf16_t* rowp = base + (size_t)(row0 + ai * 128 + m * 16) * 1024;
#pragma unroll
                for (int bj = 0; bj < 2; ++bj) { f32x4 v0 = acc[ai][bj][m][0], v1 = acc[ai][bj][m][1];
                    if (mode == 0) { v0 *= 0.125f; v1 *= 0.125f; }
                    else if (mode == 2) {
#pragma unroll
                        for (int j = 0; j < 4; ++j) { v0[j] = gelu_tanh(v0[j]); v1[j] = gelu_tanh(v1[j]); } }
                    else if (mode == 3) {
#pragma unroll
                        for (int j = 0; j < 4; ++j) { v0[j] = sigmoidf_(v0[j]); v1[j] = sigmoidf_(v1[j]); } }
                    u32x4 w; w.x = pk2(v0[0], v0[1]); w.y = pk2(v0[2], v0[3]); w.z = pk2(v1[0], v1[1]); w.w = pk2(v1[2], v1[3]);
                    *(u32x4*)(rowp + bj * 128) = w; } }
    }
};
struct EpiPlain {
    static constexpr bool PERM = true, AFTER_DRAIN = false;
    bf16_t* O; int ldc;
    __device__ __forceinline__ void operator()(const f32x4 (&acc)[2][2][4][2], const pg8::Unit& u, int wr, int wc, int fr, int fq) const {
        const int row0 = u.pm * 256 + wr * 64 + fr, col0 = u.pn * 256 + wc * 32 + 8 * fq;
#pragma unroll
        for (int ai = 0; ai < 2; ++ai)
#pragma unroll
            for (int m = 0; m < 4; ++m) { bf16_t* rowp = O + (size_t)(row0 + ai * 128 + m * 16) * ldc + col0;
#pragma unroll
                for (int bj = 0; bj < 2; ++bj) { const f32x4 v0 = acc[ai][bj][m][0], v1 = acc[ai][bj][m][1];
                    u32x4 w; w.x = pk2(v0[0], v0[1]); w.y = pk2(v0[2], v0[3]); w.z = pk2(v1[0], v1[1]); w.w = pk2(v1[2], v1[3]);
                    *(u32x4*)(rowp + bj * 128) = w; } }
    }
};
template <int STEP> struct EpiGate {
    static constexpr bool PERM = true, AFTER_DRAIN = false;
    const bf16_t* G; bf16_t* O;
    __device__ __forceinline__ void operator()(const f32x4 (&acc)[2][2][4][2], const pg8::Unit& u, int wr, int wc, int fr, int fq) const {
        const int row0 = u.pm * 256 + wr * 64 + fr, col0 = u.pn * 256 + wc * 32 + 8 * fq;
#pragma unroll
        for (int ai = 0; ai < 2; ++ai)
#pragma unroll
            for (int m = 0; m < 4; ++m) { const size_t off = (size_t)(row0 + ai * 128 + m * 16) * 1024 + col0;
#pragma unroll
                for (int bj = 0; bj < 2; ++bj) { const f32x4 v0 = acc[ai][bj][m][0], v1 = acc[ai][bj][m][1];
                    const u32x4 g = *(const u32x4*)(G + off + bj * 128);
                    float o0 = bflo(g.x) * v0[0], o1 = bfhi(g.x) * v0[1], o2 = bflo(g.y) * v0[2], o3 = bfhi(g.y) * v0[3];
                    float o4 = bflo(g.z) * v1[0], o5 = bfhi(g.z) * v1[1], o6 = bflo(g.w) * v1[2], o7 = bfhi(g.w) * v1[3];
                    if (STEP == 1) { const u32x4 p = *(const u32x4*)(O + off + bj * 128);
                        o0 += bflo(p.x); o1 += bfhi(p.x); o2 += bflo(p.y); o3 += bfhi(p.y); o4 += bflo(p.z); o5 += bfhi(p.z); o6 += bflo(p.w); o7 += bfhi(p.w); }
                    u32x4 w; w.x = pk2(o0, o1); w.y = pk2(o2, o3); w.z = pk2(o4, o5); w.w = pk2(o6, o7);
                    *(u32x4*)(O + off + bj * 128) = w; } }
    }
};
struct EpiRes {
    static constexpr bool PERM = false, AFTER_DRAIN = false;
    const float* X; float* Y; const float* ada_gate; const float* bias; int bb0, bsh;
    __device__ __forceinline__ void operator()(const f32x4 (&acc)[2][2][4][2], const pg8::Unit& u, int wr, int wc, int fr, int fq) const {
        const int row0 = u.pm * 256 + wr * 64 + fr, col0 = u.pn * 256 + wc * 32 + 4 * fq;
        const float* gp = ada_gate + (size_t)(bb0 + (u.pm >> bsh)) * 6144 + col0;
        f32x4 gv[2][2], bv[2][2];
#pragma unroll
        for (int bj = 0; bj < 2; ++bj)
#pragma unroll
            for (int n = 0; n < 2; ++n) { gv[bj][n] = *(const f32x4*)(gp + bj * 128 + n * 16); bv[bj][n] = bias ? *(const f32x4*)(bias + col0 + bj * 128 + n * 16) : (f32x4){0.f, 0.f, 0.f, 0.f}; }
#pragma unroll
        for (int ai = 0; ai < 2; ++ai)
#pragma unroll
            for (int m = 0; m < 4; ++m) { const size_t off = (size_t)(row0 + ai * 128 + m * 16) * 1024 + col0;
#pragma unroll
                for (int bj = 0; bj < 2; ++bj)
#pragma unroll
                    for (int n = 0; n < 2; ++n) { const f32x4 x = *(const f32x4*)(X + off + bj * 128 + n * 16);
                        *(f32x4*)(Y + off + bj * 128 + n * 16) = x * ALPHA + gv[bj][n] * (acc[ai][bj][m][n] + bv[bj][n]); }
                asm volatile("" ::: "memory"); }
    }
};
struct EpiFF1 {
    static constexpr bool PERM = true, AFTER_DRAIN = false;
    bf16_t* O; const float* bias;
    __device__ __forceinline__ void operator()(const f32x4 (&acc)[2][2][4][2], const pg8::Unit& u, int wr, int wc, int fr, int fq) const {
        const int row0 = u.pm * 256 + wr * 64 + fr, col0 = u.pn * 256 + wc * 32 + 8 * fq;
        f32x4 bv[2][2];
#pragma unroll
        for (int bj = 0; bj < 2; ++bj)
#pragma unroll
            for (int n = 0; n < 2; ++n) bv[bj][n] = *(const f32x4*)(bias + col0 + bj * 128 + 4 * n);
#pragma unroll
        for (int ai = 0; ai < 2; ++ai)
#pragma unroll
            for (int m = 0; m < 4; ++m) { bf16_t* rowp = O + (size_t)(row0 + ai * 128 + m * 16) * DFF + col0;
#pragma unroll
                for (int bj = 0; bj < 2; ++bj) { f32x4 v0 = acc[ai][bj][m][0] + bv[bj][0], v1 = acc[ai][bj][m][1] + bv[bj][1];
#pragma unroll
                    for (int j = 0; j < 4; ++j) { v0[j] = fmaxf(v0[j], 0.f); v0[j] *= v0[j]; v1[j] = fmaxf(v1[j], 0.f); v1[j] *= v1[j]; }
                    u32x4 w; w.x = pk2(v0[0], v0[1]); w.y = pk2(v0[2], v0[3]); w.z = pk2(v1[0], v1[1]); w.w = pk2(v1[2], v1[3]);
                    *(u32x4*)(rowp + bj * 128) = w; } }
    }
};

struct Args { const float* in[23]; float* out; unsigned char* ws; int ph_lo, ph_hi; };
enum { I_XP = 0, I_XS, I_CP, I_CS, I_WADA, I_BADA, I_WIN, I_RPB, I_SLNG, I_SLNB, I_WSP, I_BSP, I_WAUP, I_WSUP, I_WOUT, I_LN1G, I_LN1B, I_WFF1, I_BFF1, I_WFF2, I_BFF2, I_LN2G, I_LN2B };

__device__ __forceinline__ float wave_sum(float v) {
#pragma unroll
    for (int o = 1; o < 64; o <<= 1) v += __shfl_xor(v, o);
    return v;
}
__device__ __forceinline__ void transpose_item(const float* W, int K, int N, bf16_t* WT, int row_off, LAS float* scr, int kb, int nb, int lane) {
    const int k0 = 64 * kb, n0 = 32 * nb;
#pragma unroll 8
    for (int i = 0; i < 32; ++i) { const int kk = 2 * i + (lane >> 5); scr[kk * 33 + (lane & 31)] = W[(size_t)(k0 + kk) * N + n0 + (lane & 31)]; }
    asm volatile("s_waitcnt lgkmcnt(0)" ::: "memory");
    const int c = lane & 7;
#pragma unroll
    for (int j = 0; j < 4; ++j) { const int n = (lane >> 3) + 8 * j; const LAS float* s = scr + (8 * c) * 33 + n;
        u32x4 o; o.x = pk2(s[0 * 33], s[1 * 33]); o.y = pk2(s[2 * 33], s[3 * 33]); o.z = pk2(s[4 * 33], s[5 * 33]); o.w = pk2(s[6 * 33], s[7 * 33]);
        *(u32x4*)(WT + (size_t)(row_off + n0 + n) * K + k0 + 8 * c) = o; }
    asm volatile("s_waitcnt lgkmcnt(0)" ::: "memory");
}

__device__ __forceinline__ void p0_prep(const Args& a, LAS unsigned char* lds, int tid, int wave, int lane) {
    unsigned char* ws = a.ws;
    float* ADA = (float*)(ws + WS_ADA);
    if (blockIdx.x < 96) {
        LAS float* sc = (LAS float*)lds; LAS float* red = (LAS float*)(lds + 40960);
        for (int i = tid; i < 10240; i += 512) { const int b = i >> 10, k = i & 1023; const float c = b < 2 ? a.in[I_CP][b * 1024 + k] : a.in[I_CS][(b - 2) * 1024 + k]; sc[i] = c * __builtin_amdgcn_rcpf(1.0f + __expf(-c)); }
        __syncthreads();
        const int col = blockIdx.x * 64 + lane; const float* wp = a.in[I_WADA] + col;
        float acc[10];
#pragma unroll
        for (int b = 0; b < 10; ++b) acc[b] = 0.f;
#pragma unroll 4
        for (int k = wave * 128; k < wave * 128 + 128; ++k) { const float w = wp[(size_t)k * 6144];
#pragma unroll
            for (int b = 0; b < 10; ++b) acc[b] += sc[b * 1024 + k] * w; }
#pragma unroll
        for (int b = 0; b < 10; ++b) red[(wave * 10 + b) * 64 + lane] = acc[b];
        __syncthreads();
        for (int i = tid; i < 640; i += 512) { const int b = i >> 6, l = i & 63; float s = 0.f;
#pragma unroll
            for (int w = 0; w < 8; ++w) s += red[(w * 10 + b) * 64 + l];
            ADA[b * 6144 + blockIdx.x * 64 + l] = s + a.in[I_BADA][blockIdx.x * 64 + l]; }
        __syncthreads();
    }
    { bf16_t* WSB = (bf16_t*)(ws + WS_WSB); const float* w_s = a.in[I_WSP];
      for (int i = blockIdx.x * 512 + tid; i < 131072 / 2; i += gridDim.x * 512) { const f32x2v v = *(const f32x2v*)(w_s + 2 * i); *(unsigned*)(WSB + 2 * i) = pk2(v.x, v.y); } }
    LAS float* scr = (LAS float*)(lds + wave * 16384);
    const int gw = blockIdx.x * 8 + wave, NGW = gridDim.x * 8;
    constexpr int I_IN = 16 * 144, I_A = 8 * 32, I_S = 8 * 32, I_O = 16 * 32, I_1 = 16 * 128, I_2 = 64 * 32, NIT = I_IN + I_A + I_S + I_O + I_1 + I_2;
    for (int it = gw; it < NIT; it += NGW) {
        int r = it;
        if (r < I_IN) { const int kb = r / 144, nb = r % 144, n0 = nb * 32; const int ro = n0 < 1024 ? 0 : (n0 < 1536 ? 3072 : -512);
            transpose_item(a.in[I_WIN], 1024, 4608, (bf16_t*)(ws + WS_WIN), ro, scr, kb, nb, lane); continue; } r -= I_IN;
        if (r < I_A) { transpose_item(a.in[I_WAUP], 512, 1024, (bf16_t*)(ws + WS_WA), 0, scr, r / 32, r % 32, lane); continue; } r -= I_A;
        if (r < I_S) { transpose_item(a.in[I_WSUP], 512, 1024, (bf16_t*)(ws + WS_WS), 0, scr, r / 32, r % 32, lane); continue; } r -= I_S;
        if (r < I_O) { transpose_item(a.in[I_WOUT], 1024, 1024, (bf16_t*)(ws + WS_WO), 0, scr, r / 32, r % 32, lane); continue; } r -= I_O;
        if (r < I_1) { transpose_item(a.in[I_WFF1], 1024, 4096, (bf16_t*)(ws + WS_W1), 0, scr, r / 128, r % 128, lane); continue; } r -= I_1;
        transpose_item(a.in[I_WFF2], 4096, 1024, (bf16_t*)(ws + WS_W2), 0, scr, r / 32, r % 32, lane);
    }
}

__device__ __forceinline__ void modulate_rows(const float* X, bf16_t* H, const float* ada_shift, int bb0, int tsh, int gw, int ngw, int lane) {
    for (int row = gw; row < NTOK; row += ngw) {
        const float* sh = ada_shift + (size_t)(bb0 + (row >> tsh)) * 6144; const float* scl = sh + 1024;
        const f32x4* xr = (const f32x4*)(X + (size_t)row * D) + lane; u32x2* o = (u32x2*)(H + (size_t)row * D) + lane;
#pragma unroll
        for (int j = 0; j < 4; ++j) { const f32x4 v = xr[64 * j], s = ((const f32x4*)scl)[lane + 64 * j], t = ((const f32x4*)sh)[lane + 64 * j];
            const f32x4 h = v * (s + 1.0f) + t; u32x2 w; w.x = pk2(h[0], h[1]); w.y = pk2(h[2], h[3]); o[64 * j] = w; }
    }
}
__device__ __forceinline__ void ln_rows(float* Y, bf16_t* H2, const float* g, const float* b, const float* ada_shift, int bb0, int tsh, int gw, int ngw, int lane) {
    for (int row = gw; row < NTOK; row += ngw) {
        f32x4* yr = (f32x4*)(Y + (size_t)row * D) + lane;
        f32x4 v[4]; float s = 0.f;
#pragma unroll
        for (int j = 0; j < 4; ++j) { v[j] = yr[64 * j]; s += (v[j][0] + v[j][1]) + (v[j][2] + v[j][3]); }
        const float mean = wave_sum(s) * (1.f / D); float s2 = 0.f;
#pragma unroll
        for (int j = 0; j < 4; ++j) { v[j] = v[j] - mean; s2 += (v[j][0] * v[j][0] + v[j][1] * v[j][1]) + (v[j][2] * v[j][2] + v[j][3] * v[j][3]); }
        const float rstd = 1.0f / sqrtf(wave_sum(s2) * (1.f / D) + LN_EPS);
#pragma unroll
        for (int j = 0; j < 4; ++j) { v[j] = v[j] * rstd * ((const f32x4*)g)[lane + 64 * j] + ((const f32x4*)b)[lane + 64 * j]; yr[64 * j] = v[j]; }
        if (H2) { const float* sh = ada_shift + (size_t)(bb0 + (row >> tsh)) * 6144; const float* scl = sh + 1024; u32x2* o = (u32x2*)(H2 + (size_t)row * D) + lane;
#pragma unroll
            for (int j = 0; j < 4; ++j) { const f32x4 h = v[j] * (((const f32x4*)scl)[lane + 64 * j] + 1.0f) + ((const f32x4*)sh)[lane + 64 * j];
                u32x2 w; w.x = pk2(h[0], h[1]); w.y = pk2(h[2], h[3]); o[64 * j] = w; } }
    }
}

__device__ __forceinline__ void sgu_chunk(const bf16_t* UVS, const bf16_t* WSB, const float* lng, const float* lnb, const float* bsp, bf16_t* SGU, LAS unsigned char* lds, int chunk, int tid, int wave, int lane) {
    const int tok0 = chunk * 128;
    LAS f32x2v* stat = (LAS f32x2v*)(lds + LDS_STAT);
    { const int t = tid >> 2, part = tid & 3; const bf16_t* p = UVS + (size_t)(tok0 + t) * 1024 + 512 + part * 128; float s = 0.f, ss = 0.f;
#pragma unroll
      for (int i = 0; i < 16; ++i) { const u32x4 w = *(const u32x4*)(p + i * 8);
          const float e0 = bflo(w.x), e1 = bfhi(w.x), e2 = bflo(w.y), e3 = bfhi(w.y), e4 = bflo(w.z), e5 = bfhi(w.z), e6 = bflo(w.w), e7 = bfhi(w.w);
          s += ((e0 + e1) + (e2 + e3)) + ((e4 + e5) + (e6 + e7)); ss += ((e0 * e0 + e1 * e1) + (e2 * e2 + e3 * e3)) + ((e4 * e4 + e5 * e5) + (e6 * e6 + e7 * e7)); }
      s += __shfl_xor(s, 1); s += __shfl_xor(s, 2); ss += __shfl_xor(ss, 1); ss += __shfl_xor(ss, 2);
      const float mean = s * (1.f / 512.f), var = fmaxf(ss * (1.f / 512.f) - mean * mean, 0.f);
      if (part == 0) stat[t] = (f32x2v){mean, 1.0f / sqrtf(var + LN_EPS)}; }
    __syncthreads();
    const int g = wave, l15 = lane & 15, s4 = lane >> 4;
    LAS unsigned char* vt = lds + g * 16384;
#pragma unroll
    for (int hh = 0; hh < 2; ++hh) { const int t = lane + 64 * hh; const f32x2v st = stat[t]; const bf16_t* p = UVS + (size_t)(tok0 + t) * 1024 + 512 + g * 64;
#pragma unroll
        for (int c8 = 0; c8 < 8; ++c8) { const u32x4 w = *(const u32x4*)(p + c8 * 8); const unsigned ww[4] = {w.x, w.y, w.z, w.w};
#pragma unroll
            for (int e = 0; e < 8; ++e) { const int c = c8 * 8 + e; const float x = (e & 1) ? bfhi(ww[e >> 1]) : bflo(ww[e >> 1]);
                const float y = (x - st.x) * st.y * lng[g * 64 + c] + lnb[g * 64 + c];
                const int addr = c * 256 + ((((t >> 3) ^ (c & 15)) << 4) | ((t & 7) * 2));
                *(LAS bf16_t*)(vt + addr) = (bf16_t)(pk2(y, 0.f) & 0xffffu); } } }
    asm volatile("s_waitcnt lgkmcnt(0)" ::: "memory");
    bf16x8 af[4][4];
#pragma unroll
    for (int ct = 0; ct < 4; ++ct)
#pragma unroll
        for (int kk = 0; kk < 4; ++kk) af[ct][kk] = *(const LAS bf16x8*)(vt + (ct * 16 + l15) * 256 + (((kk * 4 + s4) ^ l15) << 4));
#pragma unroll 1
    for (int pt = 0; pt < 8; ++pt) {
        const bf16_t* wp = WSB + (size_t)(g * 128 + pt * 16 + l15) * 128 + s4 * 8;
        bf16x8 bf[4];
#pragma unroll
        for (int kk = 0; kk < 4; ++kk) bf[kk] = *(const bf16x8*)(wp + kk * 32);
        f32x4 acc[4];
#pragma unroll
        for (int ct = 0; ct < 4; ++ct) { acc[ct] = (f32x4){0.f, 0.f, 0.f, 0.f};
#pragma unroll
            for (int kk = 0; kk < 4; ++kk) acc[ct] = __builtin_amdgcn_mfma_f32_16x16x32_bf16(af[ct][kk], bf[kk], acc[ct], 0, 0, 0); }
        const int p = pt * 16 + l15; const float bias = bsp[g * 128 + p];
#pragma unroll
        for (int ct = 0; ct < 4; ++ct) { const int c = g * 64 + ct * 16 + s4 * 4;
            const u32x2 uu = *(const u32x2*)(UVS + (size_t)(tok0 + p) * 1024 + c);
            u32x2 w; w.x = pk2(bflo(uu.x) * (acc[ct][0] + bias), bfhi(uu.x) * (acc[ct][1] + bias)); w.y = pk2(bflo(uu.y) * (acc[ct][2] + bias), bfhi(uu.y) * (acc[ct][3] + bias));
            *(u32x2*)(SGU + (size_t)(tok0 + p) * 512 + c) = w; }
    }
    __syncthreads();
}

__device__ __forceinline__ void attn_item(const bf16_t* QK, const bf16_t* VT, bf16_t* ATT, const LAS float* rpb, int item, int rows_pb, int lane) {
    const int cb = item & 3, h = (item >> 2) & 7, R = item >> 5;
    const int b = R / rows_pb, r = R - b * rows_pb;
    int rs = r - 4; rs = rs < 0 ? 0 : (rs > rows_pb - 8 ? rows_pb - 8 : rs);
    const int kc0 = cb == 0 ? 0 : (cb == 1 ? 8 : (cb == 2 ? 24 : 32));
    const int l15 = lane & 15, s4 = lane >> 4;
    const int tq = R * 64 + cb * 16 + l15;
    const bf16_t* qp = QK + (size_t)tq * 1024 + h * 64 + s4 * 8;
    const bf16x8 qf0 = *(const bf16x8*)qp, qf1 = *(const bf16x8*)(qp + 32);
    const int krow0 = (b * rows_pb + rs) * 64;
    const bf16_t* kbase = QK + (size_t)(krow0 + kc0 + (l15 >> 2) * 8 + (l15 & 3)) * 1024 + 512 + h * 64 + s4 * 8;
    f32x4 sc[16];
#pragma unroll
    for (int i = 0; i < 8; ++i)
#pragma unroll
        for (int hf = 0; hf < 2; ++hf) { const bf16_t* kp = kbase + (size_t)(i * 64 + hf * 4) * 1024;
            const bf16x8 k0 = *(const bf16x8*)kp, k1 = *(const bf16x8*)(kp + 32);
            f32x4 z = (f32x4){0.f, 0.f, 0.f, 0.f};
            z = __builtin_amdgcn_mfma_f32_16x16x32_bf16(k0, qf0, z, 0, 0, 0); z = __builtin_amdgcn_mfma_f32_16x16x32_bf16(k1, qf1, z, 0, 0, 0); sc[i * 2 + hf] = z; }
    const int qc = cb * 16 + l15; int cs = qc - 8; cs = cs < 0 ? 0 : (cs > 48 ? 48 : cs);
    const LAS float* rp = rpb + h * 465 + (rs - r + 7) * 31;
    float mx = -3.0e38f;
#pragma unroll
    for (int i = 0; i < 8; ++i)
#pragma unroll
        for (int hf = 0; hf < 2; ++hf)
#pragma unroll
            for (int j = 0; j < 4; ++j) { const int kc = kc0 + s4 * 8 + hf * 4 + j; const bool valid = (kc >= cs) && (kc < cs + 16);
                int dc = kc - qc + 15; dc = dc < 0 ? 0 : (dc > 30 ? 30 : dc);
                const float v = valid ? sc[i * 2 + hf][j] + rp[i * 31 + dc] : -3.0e38f; sc[i * 2 + hf][j] = v; mx = fmaxf(mx, v); }
    mx = fmaxf(mx, __shfl_xor(mx, 16)); mx = fmaxf(mx, __shfl_xor(mx, 32));
    float sum = 0.f;
#pragma unroll
    for (int t = 0; t < 16; ++t)
#pragma unroll
        for (int j = 0; j < 4; ++j) { const float p = __builtin_amdgcn_exp2f((sc[t][j] - mx) * 1.4426950408889634f); sc[t][j] = p; sum += p; }
    sum += __shfl_xor(sum, 16); sum += __shfl_xor(sum, 32);
    const float inv = 1.0f / sum;
    f32x4 o[4];
#pragma unroll
    for (int dt = 0; dt < 4; ++dt) o[dt] = (f32x4){0.f, 0.f, 0.f, 0.f};
    const bf16_t* vbase = VT + (size_t)(h * 64 + l15) * NTOK + krow0 + kc0 + s4 * 8;
#pragma unroll
    for (int i = 0; i < 8; ++i) {
        u32x4 pw; pw.x = pk2(sc[2 * i][0], sc[2 * i][1]); pw.y = pk2(sc[2 * i][2], sc[2 * i][3]); pw.z = pk2(sc[2 * i + 1][0], sc[2 * i + 1][1]); pw.w = pk2(sc[2 * i + 1][2], sc[2 * i + 1][3]);
        const bf16x8 pf = __builtin_bit_cast(bf16x8, pw);
#pragma unroll
        for (int dt = 0; dt < 4; ++dt) { const bf16x8 vf = *(const bf16x8*)(vbase + (size_t)(dt * 16) * NTOK + i * 64);
            o[dt] = __builtin_amdgcn_mfma_f32_16x16x32_bf16(vf, pf, o[dt], 0, 0, 0); }
    }
    bf16_t* op = ATT + (size_t)tq * 512 + h * 64 + s4 * 4;
#pragma unroll
    for (int dt = 0; dt < 4; ++dt) { u32x2 w; w.x = pk2(o[dt][0] * inv, o[dt][1] * inv); w.y = pk2(o[dt][2] * inv, o[dt][3] * inv); *(u32x2*)(op + dt * 16) = w; }
}


__device__ __forceinline__ int att_rs(int r, int rows_pb) { int rs = r - 4; return rs < 0 ? 0 : (rs > rows_pb - 8 ? rows_pb - 8 : rs); }
__device__ __forceinline__ void attn_unit(const bf16_t* QK, const bf16_t* VT, bf16_t* ATT, const float* rpb_g, LAS unsigned char* lds, int unit, int rows_pb, int tid, int wave, int lane) {
    const int strips = rows_pb >> 4, h = unit & 7, bs = unit >> 3, b = bs / strips, strip = bs - b * strips, r0 = strip * 16;
    LAS unsigned char* kring = lds; LAS unsigned char* vring = lds + LDS_VRING; LAS float* rpb = (LAS float*)(lds + LDS_RPB);
    for (int i = tid; i < 465; i += 512) rpb[i] = rpb_g[h * 465 + i];
    const int ltok = tid >> 3, lch = tid & 7;
    const bf16_t* ksrc = QK + ((size_t)(b * rows_pb) * 64 + ltok) * 1024 + 512 + h * 64 + lch * 8;
    const bf16_t* vsrc = VT + (size_t)(h * 64 + ltok) * NTOK + (size_t)(b * rows_pb) * 64 + lch * 8;
    const int kdst = ltok * 128 + ((lch ^ ((((ltok >> 3) & 3) << 1) | ((ltok >> 1) & 1))) << 4);
    const int vdst = ltok * 128 + ((lch ^ ((ltok >> 1) & 7)) << 4);
    int hi = att_rs(r0, rows_pb) - 1;
    { const int need = att_rs(r0 + 1, rows_pb) + 7;
      for (int n = hi + 1; n <= need; ++n) { const int slot = n % 9;
          const u32x4 kv = *(const u32x4*)(ksrc + (size_t)n * 65536), vv = *(const u32x4*)(vsrc + (size_t)n * 64);
          *(LAS u32x4*)(kring + slot * 8192 + kdst) = kv; *(LAS u32x4*)(vring + slot * 8192 + vdst) = vv; }
      hi = need; }
    __syncthreads();
    const int cb = wave & 3, par = wave >> 2, l15 = lane & 15, s4 = lane >> 4;
    const int kc0 = cb == 0 ? 0 : (cb == 1 ? 8 : (cb == 2 ? 24 : 32));
    int koff[2][2];
#pragma unroll
    for (int hf = 0; hf < 2; ++hf) { const int T = kc0 + (l15 >> 2) * 8 + hf * 4 + (l15 & 3); const int f = (((T >> 3) & 3) << 1) | ((T >> 1) & 1);
#pragma unroll
        for (int kk = 0; kk < 2; ++kk) koff[hf][kk] = T * 128 + (((kk * 4 + s4) ^ f) << 4); }
    int voff[4];
#pragma unroll
    for (int dt = 0; dt < 4; ++dt) { const int dh = dt * 16 + l15; voff[dt] = dh * 128 + ((((kc0 >> 3) + s4) ^ ((dh >> 1) & 7)) << 4); }
    const int qc = cb * 16 + l15; int cs = qc - 8; cs = cs < 0 ? 0 : (cs > 48 ? 48 : cs);
#pragma unroll 1
    for (int it = 0; it < 8; ++it) {
        const int ra = r0 + 2 * it;
        const int nneed = it < 7 ? att_rs(ra + 3, rows_pb) + 7 : hi;
        const int nnew = nneed - hi;
        u32x4 pk0, pv0, pk1, pv1;
        if (nnew >= 1) { pk0 = *(const u32x4*)(ksrc + (size_t)(hi + 1) * 65536); pv0 = *(const u32x4*)(vsrc + (size_t)(hi + 1) * 64); }
        if (nnew >= 2) { pk1 = *(const u32x4*)(ksrc + (size_t)(hi + 2) * 65536); pv1 = *(const u32x4*)(vsrc + (size_t)(hi + 2) * 64); }
        {
            const int r = ra + par, rs = att_rs(r, rows_pb), R = b * rows_pb + r;
            const int tq = R * 64 + cb * 16 + l15;
            const bf16_t* qp = QK + (size_t)tq * 1024 + h * 64 + s4 * 8;
            const bf16x8 qf0 = *(const bf16x8*)qp, qf1 = *(const bf16x8*)(qp + 32);
            const int s0 = rs % 9;
            f32x4 sc[16];
#pragma unroll
            for (int i = 0; i < 8; ++i) { int slot = s0 + i; slot = slot >= 9 ? slot - 9 : slot; const LAS unsigned char* kr = kring + slot * 8192;
#pragma unroll
                for (int hf = 0; hf < 2; ++hf) { const bf16x8 k0 = *(const LAS bf16x8*)(kr + koff[hf][0]), k1 = *(const LAS bf16x8*)(kr + koff[hf][1]);
                    f32x4 z = (f32x4){0.f, 0.f, 0.f, 0.f};
                    z = __builtin_amdgcn_mfma_f32_16x16x32_bf16(k0, qf0, z, 0, 0, 0); z = __builtin_amdgcn_mfma_f32_16x16x32_bf16(k1, qf1, z, 0, 0, 0); sc[i * 2 + hf] = z; } }
            const LAS float* rp = rpb + (rs - r + 7) * 31;
            float mx = -3.0e38f;
#pragma unroll
            for (int i = 0; i < 8; ++i)
#pragma unroll
                for (int hf = 0; hf < 2; ++hf)
#pragma unroll
                    for (int j = 0; j < 4; ++j) { const int kc = kc0 + s4 * 8 + hf * 4 + j; const bool valid = (kc >= cs) && (kc < cs + 16);
                        int dc = kc - qc + 15; dc = dc < 0 ? 0 : (dc > 30 ? 30 : dc);
                        const float v = valid ? sc[i * 2 + hf][j] + rp[i * 31 + dc] : -3.0e38f; sc[i * 2 + hf][j] = v; mx = fmaxf(mx, v); }
            mx = fmaxf(mx, __shfl_xor(mx, 16)); mx = fmaxf(mx, __shfl_xor(mx, 32));
            float sum = 0.f;
#pragma unroll
            for (int t = 0; t < 16; ++t)
#pragma unroll
                for (int j = 0; j < 4; ++j) { const float p = __builtin_amdgcn_exp2f((sc[t][j] - mx) * 1.4426950408889634f); sc[t][j] = p; sum += p; }
            sum += __shfl_xor(sum, 16); sum += __shfl_xor(sum, 32);
            const float inv = 1.0f / sum;
            f32x4 o[4];
#pragma unroll
            for (int dt = 0; dt < 4; ++dt) o[dt] = (f32x4){0.f, 0.f, 0.f, 0.f};
#pragma unroll
            for (int i = 0; i < 8; ++i) { int slot = s0 + i; slot = slot >= 9 ? slot - 9 : slot; const LAS unsigned char* vr = vring + slot * 8192;
                u32x4 pw; pw.x = pk2(sc[2 * i][0], sc[2 * i][1]); pw.y = pk2(sc[2 * i][2], sc[2 * i][3]); pw.z = pk2(sc[2 * i + 1][0], sc[2 * i + 1][1]); pw.w = pk2(sc[2 * i + 1][2], sc[2 * i + 1][3]);
                const bf16x8 pf = __builtin_bit_cast(bf16x8, pw);
#pragma unroll
                for (int dt = 0; dt < 4; ++dt) { const bf16x8 vf = *(const LAS bf16x8*)(vr + voff[dt]); o[dt] = __builtin_amdgcn_mfma_f32_16x16x32_bf16(vf, pf, o[dt], 0, 0, 0); } }
            bf16_t* op = ATT + (size_t)tq * 512 + h * 64 + s4 * 4;
#pragma unroll
            for (int dt = 0; dt < 4; ++dt) { u32x2 w; w.x = pk2(o[dt][0] * inv, o[dt][1] * inv); w.y = pk2(o[dt][2] * inv, o[dt][3] * inv); *(u32x2*)(op + dt * 16) = w; }
        }
        __syncthreads();
        if (nnew >= 1) { const int slot = (hi + 1) % 9; *(LAS u32x4*)(kring + slot * 8192 + kdst) = pk0; *(LAS u32x4*)(vring + slot * 8192 + vdst) = pv0; }
        if (nnew >= 2) { const int slot = (hi + 2) % 9; *(LAS u32x4*)(kring + slot * 8192 + kdst) = pk1; *(LAS u32x4*)(vring + slot * 8192 + vdst) = pv1; }
        hi = nneed;
        __syncthreads();
    }
}

constexpr size_t WS_BAR = WS_END;
constexpr size_t WS_END2 = WS_BAR + 16384;
constexpr int LDS_XB = LDS_BYTES - 16;
#ifndef PROBE_PH
#define PROBE_PH 1000
#define PROBE_EXTRA 0
#else
#define PROBE_EXTRA 1
#endif
#ifdef ONLY_SUB
#define EN(k) ((k) == ONLY_SUB)
#else
#define EN(k) true
#endif
__global__ void __launch_bounds__(512, 2) mk_fwd(Args a) {
    extern __shared__ __attribute__((aligned(16))) unsigned char lds_raw[];
    LAS unsigned char* lds = (LAS unsigned char*)lds_raw;
    cg::grid_group grid = cg::this_grid();
    if (threadIdx.x < 4) ((LAS unsigned*)(lds + LDS_XB))[threadIdx.x] = 0u;
    __syncthreads();
    XcdBarrier xbar = xcd_barrier_post((unsigned*)(a.ws + WS_BAR), (volatile LAS unsigned*)(lds + LDS_XB));
#pragma unroll 1
    for (int step = a.ph_lo; step < a.ph_hi + PROBE_EXTRA; ++step) {
        const int ph = step <= PROBE_PH ? step : step - PROBE_EXTRA;
    int tid_l = threadIdx.x; asm volatile("" : "+v"(tid_l)); const int tid = tid_l, lane = tid & 63, wave = __builtin_amdgcn_readfirstlane(tid >> 6);
    const int G = gridDim.x, gw = blockIdx.x * 8 + wave, ngw = G * 8;
    unsigned char* ws = a.ws; asm volatile("" : "+s"(ws));
    const float* ADA = (const float*)(ws + WS_ADA);
    bf16_t* H = (bf16_t*)(ws + WS_H); bf16_t* Z = (bf16_t*)(ws + WS_Z); bf16_t* VT = (bf16_t*)(ws + WS_VT); bf16_t* ATT = (bf16_t*)(ws + WS_ATT); bf16_t* SGU = (bf16_t*)(ws + WS_SGU);
    bf16_t* QK = Z; bf16_t* UVS = Z + (size_t)NTOK * 1024; bf16_t* GA = Z + (size_t)2 * NTOK * 1024; bf16_t* GB = Z + (size_t)3 * NTOK * 1024;
    const bf16_t* WinT = (const bf16_t*)(ws + WS_WIN); const bf16_t* WaT = (const bf16_t*)(ws + WS_WA); const bf16_t* WsT = (const bf16_t*)(ws + WS_WS);
    const bf16_t* WoT = (const bf16_t*)(ws + WS_WO); const bf16_t* W1T = (const bf16_t*)(ws + WS_W1); const bf16_t* W2T = (const bf16_t*)(ws + WS_W2);
        if (ph == 0 && EN(-1)) { p0_prep(a, lds, tid, wave, lane); }
        else {
            const int ck = (ph - 1) / 9, sub = (ph - 1) % 9;
            const float* X = ck == 0 ? a.in[I_XP] : a.in[I_XS]; float* OUT = a.out + (size_t)ck * NTOK * D;
            const int bb0 = ck == 0 ? 0 : 2, tsh = ck == 0 ? 14 : 12, bsh = tsh - 8, rows_pb = ck == 0 ? 256 : 64;
            if (sub == 0 && EN(0)) { modulate_rows(X, H, ADA, bb0, tsh, gw, ngw, lane); }
            else if (sub == 1 && EN(1)) {
                { pg8::Gemm g{H, WinT, NTOK, 4096, 1024}; pg8::StaticOrder S; S.init(NTOK, 4096, G, (int)blockIdx.x); EpiZ E{Z};
                  pg8::gemm_phase<EpiZ, pg8::StaticOrder, false>(lds, g, S, E, nullptr); }
                { pg8::Gemm g{WinT + (size_t)4096 * 1024, H, 512, NTOK, 1024}; pg8::StaticOrder S; S.init(512, NTOK, G, (int)blockIdx.x); EpiPlain E{VT, NTOK};
                  pg8::gemm_phase<EpiPlain, pg8::StaticOrder, false>(lds, g, S, E, nullptr); }
            }
            else if (sub == 2 && EN(2)) {
                for (int ch = blockIdx.x; ch < NTOK / 128; ch += G)
                    sgu_chunk(UVS, (const bf16_t*)(ws + WS_WSB), a.in[I_SLNG], a.in[I_SLNB], a.in[I_BSP], SGU, lds, ch, tid, wave, lane);
                __syncthreads();
                for (int un = blockIdx.x; un < 256; un += G) attn_unit(QK, VT, ATT, a.in[I_RPB], lds, un, rows_pb, tid, wave, lane);
            }
            else if (sub == 3 && EN(3)) {
                { pg8::Gemm g{ATT, WaT, NTOK, 1024, 512}; pg8::StaticOrder S; S.init(NTOK, 1024, G, (int)blockIdx.x); EpiGate<0> E{GA, H};
                  pg8::gemm_phase<EpiGate<0>, pg8::StaticOrder, false>(lds, g, S, E, nullptr); }
                { pg8::Gemm g{SGU, WsT, NTOK, 1024, 512}; pg8::StaticOrder S; S.init(NTOK, 1024, G, (int)blockIdx.x); EpiGate<1> E{GB, H};
                  pg8::gemm_phase<EpiGate<1>, pg8::StaticOrder, false>(lds, g, S, E, nullptr); }
            }
            else if (sub == 4 && EN(4)) { pg8::Gemm g{H, WoT, NTOK, 1024, 1024}; pg8::StaticOrder S; S.init(NTOK, 1024, G, (int)blockIdx.x); EpiRes E{X, OUT, ADA + 2 * 1024, nullptr, bb0, bsh};
                pg8::gemm_phase<EpiRes, pg8::StaticOrder, false>(lds, g, S, E, nullptr); }
            else if (sub == 5 && EN(5)) { ln_rows(OUT, H, a.in[I_LN1G], a.in[I_LN1B], ADA + 3 * 1024, bb0, tsh, gw, ngw, lane); }
            else if (sub == 6 && EN(6)) { pg8::Gemm g{H, W1T, NTOK, 4096, 1024}; pg8::StaticOrder S; S.init(NTOK, 4096, G, (int)blockIdx.x); EpiFF1 E{Z, a.in[I_BFF1]};
                pg8::gemm_phase<EpiFF1, pg8::StaticOrder, false>(lds, g, S, E, nullptr); }
            else if (sub == 7 && EN(7)) { pg8::Gemm g{Z, W2T, NTOK, 1024, 4096}; pg8::StaticOrder S; S.init(NTOK, 1024, G, (int)blockIdx.x); EpiRes E{OUT, OUT, ADA + 5 * 1024, a.in[I_BFF2], bb0, bsh};
                pg8::gemm_phase<EpiRes, pg8::StaticOrder, false>(lds, g, S, E, nullptr); }
            else if (EN(8)) { ln_rows(OUT, nullptr, a.in[I_LN2G], a.in[I_LN2B], ADA, bb0, tsh, gw, ngw, lane); }
        }
        if (step + 1 < a.ph_hi + PROBE_EXTRA) { if (step == 0) { __threadfence(); grid.sync(); } else xcd_barrier(xbar); }
    }
}

extern "C" void kernel_launch(void* const* d_in, const int* in_sizes, int n_in, void* d_out, int out_size, void* d_ws, size_t ws_size, hipStream_t stream) {
    static int grid = 0;
    if (grid == 0) {
        if (n_in != 23 || ws_size < WS_END2) { fprintf(stderr, "kernel_launch: n_in %d ws %zu (need %zu)\n", n_in, ws_size, (size_t)WS_END2); grid = -1; return; }
        int dev = 0, cus = 0, per_cu = 0;
        hipGetDevice(&dev); hipDeviceGetAttribute(&cus, hipDeviceAttributeMultiprocessorCount, dev);
        if (hipFuncSetAttribute((const void*)mk_fwd, hipFuncAttributeMaxDynamicSharedMemorySize, LDS_BYTES) != hipSuccess) { fprintf(stderr, "kernel_launch: hipFuncSetAttribute failed\n"); grid = -1; return; }
        hipOccupancyMaxActiveBlocksPerMultiprocessor(&per_cu, (const void*)mk_fwd, 512, LDS_BYTES);
        (void)hipGetLastError();
        if (per_cu < 1) fprintf(stderr, "kernel_launch: occupancy query says %d blocks per CU\n", per_cu);
        grid = cus > 0 ? cus : 256;
    }
    if (grid < 0) return;
    Args a{};
    for (int i = 0; i < 23; ++i) a.in[i] = (const float*)d_in[i];
    a.out = (float*)d_out; a.ws = (unsigned char*)d_ws;
    if (hipMemsetAsync((char*)d_ws + WS_BAR, 0, 16384, stream) != hipSuccess) { fprintf(stderr, "memset failed\n"); return; }
#if MK_MULTI
    for (int ph = 0; ph < NPH; ++ph) { a.ph_lo = ph; a.ph_hi = ph + 1; hipLaunchKernelGGL(mk_fwd, dim3(grid), dim3(512), LDS_BYTES, stream, a); }
#else
    a.ph_lo = 0; a.ph_hi = NPH;
    void* args[] = {&a};
    hipError_t e = hipLaunchCooperativeKernel((const void*)mk_fwd, dim3(grid), dim3(512), args, LDS_BYTES, stream);
    if (e != hipSuccess) fprintf(stderr, "cooperative launch failed: %s (grid %d)\n", hipGetErrorString(e), grid);
#endif
}
```
